# Optimizing an MI355X kernel written in HIP

```python
import math
import jax
import jax.numpy as jnp
from jax import lax
import numpy as np

D_MODEL = 2048
BATCH = 4
SEQ = 2048
DEPTH = 4

MEM_LEN = 256
EPS = 1e-5
NEG_INF = -1e30
H_A = 8
D_A = 64
W_A = H_A * 2 * D_A
DILATED_GROUPS = ((128, 1), (512, 4), (2048, 16))
N_GROUPS = 3
HB_PER_GROUP = 4
D_B = 128
W_BQKV = N_GROUPS * HB_PER_GROUP * D_B
W_B = HB_PER_GROUP * D_B
H_C = 4
D_C = 128
W_C = H_C * D_C
IN_WIDTHS = (W_A, W_A, W_A, W_BQKV, W_BQKV, W_BQKV, W_C)
N_IN = 3 * W_A + 3 * W_BQKV + W_C
N_BRANCH = 3
NUM_BUCKETS = 32
REL_MAX_DISTANCE = 1024
N_BIAS_COLS = 2 * H_A + N_GROUPS * HB_PER_GROUP
Q_BLOCK = 128
D_FF = -(-8 * D_MODEL // (3 * 256)) * 256

kernel_name = "hybrid_diff_dilated_mem_encoder"


def rmsnorm(t, g):
    tf = t.astype(jnp.float32)
    tf = tf * lax.rsqrt(jnp.mean(tf * tf, axis=-1, keepdims=True) + EPS)
    return (tf * g.astype(jnp.float32)).astype(t.dtype)


def rel_bucket(rel):
    half_b = NUM_BUCKETS // 2
    max_exact = half_b // 2
    n = jnp.abs(rel)
    nf = jnp.maximum(n, 1).astype(jnp.float32)
    large = max_exact + (jnp.log(nf / max_exact) / math.log(REL_MAX_DISTANCE / max_exact)
                         * (half_b - max_exact)).astype(jnp.int32)
    large = jnp.minimum(large, half_b - 1)
    return jnp.where(rel > 0, half_b, 0) + jnp.where(n < max_exact, n, large)


def diff_attention(q, k, v, lam, lam_init, sub_gain, bias_tab):
    b, s = q.shape[0], q.shape[1]
    nq = s // Q_BLOCK
    scale = D_A ** -0.5
    kpos = jnp.arange(s)

    def one_block(args):
        qb, i0 = args
        rel = kpos[None, :] - (i0 + jnp.arange(Q_BLOCK))[:, None]
        bias = bias_tab[rel_bucket(rel)].reshape(Q_BLOCK, s, 2, H_A).transpose(3, 2, 0, 1)
        logits = jnp.einsum("bqhmd,bkhmd->bhmqk", qb, k).astype(jnp.float32) * scale + bias.astype(jnp.float32)
        p = jax.nn.softmax(logits, axis=-1)
        a = (p[:, :, 0] - lam * p[:, :, 1]).astype(v.dtype)
        return jnp.einsum("bhqk,bkhe->bqhe", a, v)

    qs = q.reshape(b, nq, Q_BLOCK, H_A, 2, D_A).transpose(1, 0, 2, 3, 4, 5)
    o = lax.map(one_block, (qs, jnp.arange(nq) * Q_BLOCK))
    o = o.transpose(1, 0, 2, 3, 4).reshape(b, s, H_A, 2 * D_A)
    o = rmsnorm(o, sub_gain) * (1.0 - lam_init)
    return o.reshape(b, s, W_A)


def dilated_group(q, k, v, bias_tab, window, dilation):
    b, s, hg, hd = q.shape
    half = window // (2 * dilation)
    L = s // dilation
    blk = half
    nb = -(-L // blk)
    lp = nb * blk

    def to_residue(t):
        t = t.reshape(b, L, dilation, hg, hd).transpose(0, 3, 2, 1, 4)
        return jnp.pad(t, ((0, 0), (0, 0), (0, 0), (0, lp - L), (0, 0)))

    def band(t):
        t = jnp.pad(t, ((0, 0), (0, 0), (0, 0), (blk, blk), (0, 0))).reshape(b, hg, dilation, nb + 2, blk, hd)
        return jnp.concatenate([t[:, :, :, :-2], t[:, :, :, 1:-1], t[:, :, :, 2:]], axis=4)

    qb = to_residue(q).reshape(b, hg, dilation, nb, blk, hd)
    kb = band(to_residue(k))
    vb = band(to_residue(v))
    kj = jnp.arange(3 * blk)[None, :] - blk
    step = kj - jnp.arange(blk)[:, None]
    bias = bias_tab[rel_bucket(step * dilation)].transpose(2, 0, 1)
    kidx = jnp.arange(nb)[:, None] * blk + kj
    valid = (jnp.abs(step) <= half)[None] & ((kidx >= 0) & (kidx < L))[:, None, :]
    logits = jnp.einsum("bhrnqd,bhrnkd->bhrnqk", qb, kb).astype(jnp.float32) * (hd ** -0.5) \
        + bias[None, :, None, None].astype(jnp.float32)
    logits = jnp.where(valid, logits, NEG_INF)
    lse = jax.nn.logsumexp(logits, axis=-1)
    p = jnp.exp(logits - lse[..., None]).astype(v.dtype)
    o = jnp.einsum("bhrnqk,bhrnkd->bhrnqd", p, vb)
    o = o.reshape(b, hg, dilation, lp, hd)[:, :, :, :L].transpose(0, 3, 2, 1, 4).reshape(b, s, hg, hd)
    lse = lse.reshape(b, hg, dilation, lp)[..., :L].transpose(0, 3, 2, 1).reshape(b, s, hg)
    return o, lse


def dilated_attention(q, k, v, bias_tab):
    b, s = q.shape[0], q.shape[1]
    q, k, v = (t.reshape(b, s, N_GROUPS, HB_PER_GROUP, D_B) for t in (q, k, v))
    outs, lses = [], []
    for g, (window, dilation) in enumerate(DILATED_GROUPS):
        cols = bias_tab[:, g * HB_PER_GROUP:(g + 1) * HB_PER_GROUP]
        o, lse = dilated_group(q[:, :, g], k[:, :, g], v[:, :, g], cols, window, dilation)
        outs.append(o)
        lses.append(lse)
    alpha = jax.nn.softmax(jnp.stack(lses), axis=0)
    o = jnp.sum(alpha[..., None] * jnp.stack(outs).astype(jnp.float32), axis=0)
    return o.astype(q.dtype).reshape(b, s, W_B)


def mem_attention(q, mem_kv):
    b, s = q.shape[0], q.shape[1]
    q = q.reshape(b, s, H_C, D_C)
    kv = mem_kv.reshape(b, mem_kv.shape[1], 2, H_C, D_C)
    logits = jnp.einsum("bshd,bmhd->bhsm", q, kv[:, :, 0]).astype(jnp.float32) * (D_C ** -0.5)
    p = jax.nn.softmax(logits, axis=-1).astype(q.dtype)
    return jnp.einsum("bhsm,bmhd->bshd", p, kv[:, :, 1]).reshape(b, s, W_C)


def setup_inputs(seed: int = 0) -> dict:
    key = jax.random.key(seed)
    ks = jax.random.split(key, 20)
    f32 = jnp.float32

    def nrm(k, shape, scale):
        return jax.random.normal(k, shape, f32) * scale

    def gain(k, shape):
        return 1.0 + 0.05 * jax.random.normal(k, shape, f32)

    return {
        "x": nrm(ks[0], (BATCH, SEQ, D_MODEL), 1.0),
        "mem": nrm(ks[1], (BATCH, MEM_LEN, D_MODEL), 1.0),
        "rel_bias": nrm(ks[2], (NUM_BUCKETS, N_BIAS_COLS), 0.5),
        "mem_norm": gain(ks[3], (D_MODEL,)),
        "attn_norm": gain(ks[4], (DEPTH, D_MODEL)),
        "w_in": nrm(ks[5], (DEPTH, D_MODEL, N_IN), D_MODEL ** -0.5),
        "diff_lambda": nrm(ks[6], (DEPTH, 4, D_A), 0.1),
        "diff_subln": gain(ks[7], (DEPTH, 2 * D_A)),
        "w_mem_kv": nrm(ks[8], (DEPTH, D_MODEL, 2 * W_C), D_MODEL ** -0.5),
        "w_gate": nrm(ks[9], (DEPTH, D_MODEL, N_BRANCH * D_MODEL), D_MODEL ** -0.5),
        "b_gate": nrm(ks[10], (DEPTH, N_BRANCH * D_MODEL), 0.1),
        "w_proj_a": nrm(ks[11], (DEPTH, W_A, D_MODEL), W_A ** -0.5),
        "w_proj_b": nrm(ks[12], (DEPTH, W_B, D_MODEL), W_B ** -0.5),
        "w_proj_c": nrm(ks[13], (DEPTH, W_C, D_MODEL), W_C ** -0.5),
        "w_out": nrm(ks[14], (DEPTH, D_MODEL, D_MODEL), D_MODEL ** -0.5),
        "ffn_norm": gain(ks[15], (DEPTH, D_MODEL)),
        "w_ffn_gate": nrm(ks[16], (DEPTH, D_MODEL, D_FF), D_MODEL ** -0.5),
        "w_ffn_up": nrm(ks[17], (DEPTH, D_MODEL, D_FF), D_MODEL ** -0.5),
        "w_ffn_down": nrm(ks[18], (DEPTH, D_FF, D_MODEL), D_FF ** -0.5),
        "final_norm": gain(ks[19], (D_MODEL,)),
    }


def reference(x, mem, rel_bias, mem_norm, attn_norm, w_in, diff_lambda, diff_subln, w_mem_kv,
              w_gate, b_gate, w_proj_a, w_proj_b, w_proj_c, w_out, ffn_norm, w_ffn_gate,
              w_ffn_up, w_ffn_down, final_norm):
    b, s, _ = x.shape
    split_at = np.cumsum(IN_WIDTHS)[:-1].tolist()
    mem_n = rmsnorm(mem, mem_norm)
    bias_a = rel_bias[:, :2 * H_A]
    bias_b = rel_bias[:, 2 * H_A:]
    for l in range(DEPTH):
        h = rmsnorm(x, attn_norm[l])
        qa, ka, va, qb, kb, vb, qc = jnp.split(h @ w_in[l], split_at, axis=-1)
        dl = diff_lambda[l].astype(jnp.float32)
        lam_init = 0.8 - 0.6 * math.exp(-0.3 * l)
        lam = jnp.exp(jnp.sum(dl[0] * dl[1])) - jnp.exp(jnp.sum(dl[2] * dl[3])) + lam_init
        o_a = diff_attention(qa.reshape(b, s, H_A, 2, D_A), ka.reshape(b, s, H_A, 2, D_A),
                             va.reshape(b, s, H_A, 2 * D_A), lam, lam_init, diff_subln[l], bias_a)
        o_b = dilated_attention(qb, kb, vb, bias_b)
        o_c = mem_attention(qc, mem_n @ w_mem_kv[l])
        gates = jax.nn.sigmoid((h @ w_gate[l] + b_gate[l]).astype(jnp.float32)).astype(h.dtype)
        gates = gates.reshape(b, s, N_BRANCH, D_MODEL)
        merged = (gates[:, :, 0] * (o_a @ w_proj_a[l])
                  + gates[:, :, 1] * (o_b @ w_proj_b[l])
                  + gates[:, :, 2] * (o_c @ w_proj_c[l]))
        x = x + merged @ w_out[l]
        h2 = rmsnorm(x, ffn_norm[l])
        x = x + (jax.nn.silu(h2 @ w_ffn_gate[l]) * (h2 @ w_ffn_up[l])) @ w_ffn_down[l]
    return rmsnorm(x, final_norm)
```

```cpp
#include <hip/hip_runtime.h>
#include <cstdio>
#include <cstdint>


#ifndef MK_PER_PHASE
#define MK_PER_PHASE 0
#endif

namespace pg8 {
#define PG8_LAS __attribute__((address_space(3)))
typedef unsigned short bf16_t;
typedef short bf16x8 __attribute__((ext_vector_type(8)));
typedef float f32x4 __attribute__((ext_vector_type(4)));
typedef unsigned u32x4 __attribute__((ext_vector_type(4)));
constexpr int BM = 256, BK = 64, HALF = 128, HTB = HALF * BK * 2, STAGE_BYTES = 8 * HTB, NXCD = 8, WGM = 8;

__host__ __device__ __forceinline__ int lds_byte(int r, int c) { const int st = (r >> 4) * 2 + (c >> 5), rr = r & 15, cc = c & 31, ob = rr * 64 + cc * 2; return st * 1024 + (ob ^ (((ob >> 9) & 1) << 5)); }
__host__ __device__ __forceinline__ void stage_rc(int b, int& R, int& C) { const int st = b / 1024, sb = b % 1024, swz = sb ^ (((sb >> 9) & 1) << 5); R = (st >> 1) * 16 + swz / 64; C = (st & 1) * 32 + (swz % 64) / 2; }
__host__ __device__ __forceinline__ int perm32(int rho) { const int n = rho >> 4, i = rho & 15; return 8 * (i >> 2) + 4 * n + (i & 3); }

struct Unit { int pm, pn; };
struct Gemm { const bf16_t* A; const bf16_t* Bt; int M, N, K; };

struct StaticOrder {
    int nM, nN, nwg, G, c;
    __host__ __device__ void init(int M, int N, int G_, int c_) { nM = M / BM; nN = N / BM; nwg = nM * nN; G = G_; c = c_; }
    __host__ __device__ bool next(int i, Unit& u) const {
        const long L = (long)i * G + c; if (L >= nwg) return false;
        int wgid = (int)L; { const int q = nwg / NXCD, r = nwg % NXCD, xcd = wgid % NXCD, off = wgid / NXCD; wgid = (xcd < r ? xcd * (q + 1) : r * (q + 1) + (xcd - r) * q) + off; }
        const int nig = WGM * nN, gid = wgid / nig, fm = gid * WGM, gsz = (nM - fm) < WGM ? (nM - fm) : WGM;
        u.pm = fm + ((wgid % nig) % gsz); u.pn = (wgid % nig) / gsz; return true;
    }
    __device__ __forceinline__ void a_ready(const Unit&) const {}
    __device__ __forceinline__ void done(const Unit&) const {}
};

__device__ __forceinline__ unsigned cvt_pk_bf16(float lo, float hi) { unsigned r; asm volatile("v_cvt_pk_bf16_f32 %0, %1, %2" : "=v"(r) : "v"(lo), "v"(hi)); return r; }
__device__ __forceinline__ float bf_lo(unsigned w) { return __uint_as_float(w << 16); }
__device__ __forceinline__ float bf_hi(unsigned w) { return __uint_as_float(w & 0xffff0000u); }
__device__ __forceinline__ float sigmoidf_(float v) { return __builtin_amdgcn_rcpf(1.0f + __builtin_amdgcn_exp2f(-1.4426950408889634f * v)); }


struct EpiInGate {
    static constexpr bool PERM = true, AFTER_DRAIN = false, HAS_MID = false;
    bf16_t* qkv; bf16_t* gate; const float* bgate; const unsigned long long* ss;
    __device__ __forceinline__ void operator()(const f32x4 (&acc)[2][2][4][2], const Unit& u, int wr, int wc, int fr, int fq) const {
        const int row0 = u.pm * BM + wr * 64 + fr; int colt = u.pn * BM;
        const bool isg = colt >= 8192;
        if (isg) colt -= 8192;
        const int col0 = colt + wc * 32 + 8 * fq;
        f32x4 bv[2][2];
#pragma unroll
        for (int bj = 0; bj < 2; ++bj)
#pragma unroll
            for (int n = 0; n < 2; ++n) bv[bj][n] = isg ? *(const f32x4*)(bgate + col0 + bj * HALF + 4 * n) : (f32x4){0.f, 0.f, 0.f, 0.f};
        const int bb = (u.pm * BM) >> 11, s0 = (row0 & 2047);
#pragma unroll
        for (int ai = 0; ai < 2; ++ai)
#pragma unroll
            for (int m = 0; m < 4; ++m) {
                const float rs = __builtin_amdgcn_rsqf((float)ss[row0 + ai * HALF + m * 16] * (1.0f / (2048.0f * 1048576.0f)) + 1e-5f);
#pragma unroll
                for (int bj = 0; bj < 2; ++bj) { f32x4 v0 = acc[ai][bj][m][0] * rs + bv[bj][0], v1 = acc[ai][bj][m][1] * rs + bv[bj][1];
                    bf16_t* dst;
                    if (isg) { dst = gate + (size_t)(row0 + ai * HALF + m * 16) * 6144 + col0 + bj * HALF;
#pragma unroll
                        for (int i = 0; i < 4; ++i) { v0[i] = fmaxf(sigmoidf_(v0[i]), 1e-30f); v1[i] = fmaxf(sigmoidf_(v1[i]), 1e-30f); } }
                    else dst = qkv + (size_t)(((((colt >> 7) + bj) * 4 + bb) * 2048) + s0 + ai * HALF + m * 16) * 128 + wc * 32 + 8 * fq;
                    u32x4 w; w.x = cvt_pk_bf16(v0[0], v0[1]); w.y = cvt_pk_bf16(v0[2], v0[3]); w.z = cvt_pk_bf16(v1[0], v1[1]); w.w = cvt_pk_bf16(v1[2], v1[3]);
                    if (isg) __builtin_nontemporal_store(w, (u32x4*)dst); else *(u32x4*)dst = w; } }
    }
};
struct EpiPlain {
    static constexpr bool PERM = true, AFTER_DRAIN = false, HAS_MID = false;
    bf16_t* O; int ldc;
    __device__ __forceinline__ void operator()(const f32x4 (&acc)[2][2][4][2], const Unit& u, int wr, int wc, int fr, int fq) const {
        const int row0 = u.pm * BM + wr * 64 + fr; const int col0 = u.pn * BM + wc * 32 + 8 * fq;
#pragma unroll
        for (int ai = 0; ai < 2; ++ai)
#pragma unroll
            for (int m = 0; m < 4; ++m) { bf16_t* rowp = O + (size_t)(row0 + ai * HALF + m * 16) * ldc + col0;
#pragma unroll
                for (int bj = 0; bj < 2; ++bj) { const f32x4 v0 = acc[ai][bj][m][0], v1 = acc[ai][bj][m][1];
                    u32x4 w; w.x = cvt_pk_bf16(v0[0], v0[1]); w.y = cvt_pk_bf16(v0[2], v0[3]); w.z = cvt_pk_bf16(v1[0], v1[1]); w.w = cvt_pk_bf16(v1[2], v1[3]);
                    *(u32x4*)(rowp + bj * HALF) = w; } }
    }
};
struct EpiProj {
    static constexpr bool PERM = true, AFTER_DRAIN = false, HAS_MID = true;
    const bf16_t* gate; bf16_t* merged;
    static __device__ __forceinline__ bool is_mid(int t) { return t == 16 || t == 24; }
    __device__ __forceinline__ void mid(f32x4 (&acc)[2][2][4][2], const Unit& u, int t, int wr, int wc, int fr, int fq) const {
        const int seg = (t == 16) ? 0 : 1;
        const int row0 = u.pm * BM + wr * 64 + fr; const int col0 = u.pn * BM + wc * 32 + 8 * fq;
        const bf16_t* gbase = gate + (size_t)row0 * 6144 + seg * 2048 + col0;
#pragma unroll
        for (int ai = 0; ai < 2; ++ai)
#pragma unroll
            for (int mh = 0; mh < 2; ++mh) {
                u32x4 a[2][2], b[2][2];
#pragma unroll
                for (int mm = 0; mm < 2; ++mm)
#pragma unroll
                    for (int bj = 0; bj < 2; ++bj) { const bf16_t* gp = gbase + (size_t)(ai * HALF + (mh * 2 + mm) * 16) * 6144 + bj * HALF; a[mm][bj] = __builtin_nontemporal_load((const u32x4*)gp); b[mm][bj] = __builtin_nontemporal_load((const u32x4*)(gp + 2048)); }
#pragma unroll
                for (int mm = 0; mm < 2; ++mm)
#pragma unroll
                    for (int bj = 0; bj < 2; ++bj) { const int m = mh * 2 + mm; const u32x4 A = a[mm][bj], B = b[mm][bj];
                        f32x4 r0, r1;
                        r0[0] = bf_lo(A.x) * __builtin_amdgcn_rcpf(bf_lo(B.x)); r0[1] = bf_hi(A.x) * __builtin_amdgcn_rcpf(bf_hi(B.x));
                        r0[2] = bf_lo(A.y) * __builtin_amdgcn_rcpf(bf_lo(B.y)); r0[3] = bf_hi(A.y) * __builtin_amdgcn_rcpf(bf_hi(B.y));
                        r1[0] = bf_lo(A.z) * __builtin_amdgcn_rcpf(bf_lo(B.z)); r1[1] = bf_hi(A.z) * __builtin_amdgcn_rcpf(bf_hi(B.z));
                        r1[2] = bf_lo(A.w) * __builtin_amdgcn_rcpf(bf_lo(B.w)); r1[3] = bf_hi(A.w) * __builtin_amdgcn_rcpf(bf_hi(B.w));
                        acc[ai][bj][m][0] = acc[ai][bj][m][0] * r0; acc[ai][bj][m][1] = acc[ai][bj][m][1] * r1; }
                __builtin_amdgcn_sched_barrier(0);
            }
    }
    __device__ __forceinline__ void operator()(const f32x4 (&acc)[2][2][4][2], const Unit& u, int wr, int wc, int fr, int fq) const {
        const int row0 = u.pm * BM + wr * 64 + fr; const int col0 = u.pn * BM + wc * 32 + 8 * fq;
#pragma unroll
        for (int ai = 0; ai < 2; ++ai)
#pragma unroll
            for (int m = 0; m < 4; ++m) { const size_t r = (size_t)(row0 + ai * HALF + m * 16); const bf16_t* gp = gate + r * 6144 + 2 * 2048 + col0; bf16_t* rowp = merged + r * 2048 + col0;
#pragma unroll
                for (int bj = 0; bj < 2; ++bj) { const u32x4 g = __builtin_nontemporal_load((const u32x4*)(gp + bj * HALF)); const f32x4 v0 = acc[ai][bj][m][0], v1 = acc[ai][bj][m][1];
                    u32x4 w; w.x = cvt_pk_bf16(v0[0] * bf_lo(g.x), v0[1] * bf_hi(g.x)); w.y = cvt_pk_bf16(v0[2] * bf_lo(g.y), v0[3] * bf_hi(g.y));
                    w.z = cvt_pk_bf16(v1[0] * bf_lo(g.z), v1[1] * bf_hi(g.z)); w.w = cvt_pk_bf16(v1[2] * bf_lo(g.w), v1[3] * bf_hi(g.w));
                    *(u32x4*)(rowp + bj * HALF) = w; } }
    }
};
struct EpiResid {
    static constexpr bool PERM = true, AFTER_DRAIN = false, HAS_MID = false;
    const float* base32; bf16_t* xb; unsigned long long* ss;
    __device__ __forceinline__ void operator()(const f32x4 (&acc)[2][2][4][2], const Unit& u, int wr, int wc, int fr, int fq) const {
        const int row0 = u.pm * BM + wr * 64 + fr; const int col0 = u.pn * BM + wc * 32 + 8 * fq;
#pragma unroll
        for (int ai = 0; ai < 2; ++ai)
#pragma unroll
            for (int m = 0; m < 4; ++m) { const int row = row0 + ai * HALF + m * 16; const size_t off = (size_t)row * 2048 + col0; float sq = 0.f;
#pragma unroll
                for (int bj = 0; bj < 2; ++bj) { f32x4 b0, b1;
                    if (base32) { b0 = *(const f32x4*)(base32 + off + bj * HALF); b1 = *(const f32x4*)(base32 + off + bj * HALF + 4); }
                    else { const u32x4 p = *(const u32x4*)(xb + off + bj * HALF); b0 = (f32x4){bf_lo(p.x), bf_hi(p.x), bf_lo(p.y), bf_hi(p.y)}; b1 = (f32x4){bf_lo(p.z), bf_hi(p.z), bf_lo(p.w), bf_hi(p.w)}; }
                    const f32x4 v0 = b0 + acc[ai][bj][m][0], v1 = b1 + acc[ai][bj][m][1];
                    u32x4 w; w.x = cvt_pk_bf16(v0[0], v0[1]); w.y = cvt_pk_bf16(v0[2], v0[3]); w.z = cvt_pk_bf16(v1[0], v1[1]); w.w = cvt_pk_bf16(v1[2], v1[3]);
                    *(u32x4*)(xb + off + bj * HALF) = w;
                    const float r0 = bf_lo(w.x), r1 = bf_hi(w.x), r2 = bf_lo(w.y), r3 = bf_hi(w.y), r4 = bf_lo(w.z), r5 = bf_hi(w.z), r6 = bf_lo(w.w), r7 = bf_hi(w.w);
                    sq += ((r0 * r0 + r1 * r1) + (r2 * r2 + r3 * r3)) + ((r4 * r4 + r5 * r5) + (r6 * r6 + r7 * r7)); }
                sq += __shfl_xor(sq, 16); sq += __shfl_xor(sq, 32);
                if (fq == 0) (void)__hip_atomic_fetch_add(ss + row, (unsigned long long)(sq * 1048576.0f + 0.5f), __ATOMIC_RELAXED, __HIP_MEMORY_SCOPE_AGENT); }
    }
};
struct EpiSwiGLU {
    static constexpr bool PERM = true, AFTER_DRAIN = false, HAS_MID = false;
    bf16_t* hid; const unsigned long long* ss;
    __device__ __forceinline__ void operator()(const f32x4 (&acc)[2][2][4][2], const Unit& u, int wr, int wc, int fr, int fq) const {
        const int row0 = u.pm * BM + wr * 64 + fr; const int col0 = u.pn * HALF + wc * 32 + 8 * fq;
#pragma unroll
        for (int ai = 0; ai < 2; ++ai)
#pragma unroll
            for (int m = 0; m < 4; ++m) { bf16_t* rowp = hid + (size_t)(row0 + ai * HALF + m * 16) * 5632 + col0;
                f32x4 h0, h1; const float rs = __builtin_amdgcn_rsqf((float)ss[row0 + ai * HALF + m * 16] * (1.0f / (2048.0f * 1048576.0f)) + 1e-5f);
#pragma unroll
                for (int i = 0; i < 4; ++i) { const float g0 = acc[ai][0][m][0][i] * rs, g1 = acc[ai][0][m][1][i] * rs;
                    h0[i] = g0 * sigmoidf_(g0) * (acc[ai][1][m][0][i] * rs); h1[i] = g1 * sigmoidf_(g1) * (acc[ai][1][m][1][i] * rs); }
                u32x4 w; w.x = cvt_pk_bf16(h0[0], h0[1]); w.y = cvt_pk_bf16(h0[2], h0[3]); w.z = cvt_pk_bf16(h1[0], h1[1]); w.w = cvt_pk_bf16(h1[2], h1[3]);
                *(u32x4*)rowp = w; }
    }
};

template <class Epi, class Sched, bool ALIGN_EPI = false, bool SP2 = false>
__device__ __forceinline__ void gemm_phase(PG8_LAS unsigned char* lds, const Gemm g, const Sched& S, const Epi& E) {
    int tid = threadIdx.x; asm volatile("" : "+v"(tid));
    const int wid = __builtin_amdgcn_readfirstlane(tid >> 6), lane = tid & 63, wr = wid >> 2, wc = wid & 3, fr = lane & 15, fq = lane >> 4;
    const int K = g.K, nt = K / BK;
    unsigned voffA[2], voffB[2];
#pragma unroll
    for (int i = 0; i < 2; ++i) { int R, C; stage_rc(tid * 16 + i * 8192, R, C); const int Rb = Epi::PERM ? ((R & ~31) + perm32(R & 31)) : R;
        voffA[i] = (unsigned)(R * K + C) * 2u; voffB[i] = (unsigned)(Rb * K + C) * 2u; }
    const size_t kstep = (size_t)(BK * 2);
    const size_t hstep = (size_t)HALF * K * 2;
    const size_t tstep = 2 * hstep;
    const unsigned ldsw = (unsigned)wid * 1024u;
    const int aoff = lds_byte(wr * 64 + fr, fq * 8), boff = lds_byte(wc * 32 + fr, fq * 8);
#define PG8_SA(b, h) (((b) * 2 + (h)) * HTB)
#define PG8_SB(b, h) ((4 + (b) * 2 + (h)) * HTB)
#define PG8_STAGE(bufoff, gbase, voff) do { _Pragma("unroll") for (int _i = 0; _i < 2; ++_i) \
        __builtin_amdgcn_global_load_lds((const unsigned*)((const char*)(gbase) + (voff)[_i]), (PG8_LAS unsigned*)(lds + (bufoff) + ldsw + _i * 8192), 16, 0, 0); } while (0)
#define PG8_LDA(dst, b, h) do { _Pragma("unroll") for (int m = 0; m < 4; ++m) _Pragma("unroll") for (int k = 0; k < 2; ++k) dst[m][k] = *(const PG8_LAS bf16x8*)(lds + PG8_SA(b, h) + aoff + m * 2048 + k * 1024); } while (0)
#define PG8_LDB(dst, b, h) do { _Pragma("unroll") for (int n = 0; n < 2; ++n) _Pragma("unroll") for (int k = 0; k < 2; ++k) dst[n][k] = *(const PG8_LAS bf16x8*)(lds + PG8_SB(b, h) + boff + n * 2048 + k * 1024); } while (0)
#define PG8_MMA(ai, bj, At, Bt) do { __builtin_amdgcn_s_setprio(1); _Pragma("unroll") for (int m = 0; m < 4; ++m) _Pragma("unroll") for (int n = 0; n < 2; ++n) _Pragma("unroll") for (int k = 0; k < 2; ++k) \
        acc[ai][bj][m][n] = __builtin_amdgcn_mfma_f32_16x16x32_bf16(Bt[n][k], At[m][k], acc[ai][bj][m][n], 0, 0, 0); __builtin_amdgcn_s_setprio(0); } while (0)
#define PG8_WAIT_V(n) asm volatile("s_waitcnt vmcnt(" #n ")" ::: "memory")
#define PG8_WAIT_L(n) asm volatile("s_waitcnt lgkmcnt(" #n ")" ::: "memory")
#define PG8_BAR __builtin_amdgcn_s_barrier()
#define PG8_SCHED __builtin_amdgcn_sched_barrier(0)
    Unit cur, nxt; int ui = 0;
    if (!S.next(0, cur)) return;
    f32x4 acc[2][2][4][2];
#pragma unroll
    for (int a = 0; a < 2; ++a)
#pragma unroll
        for (int b = 0; b < 2; ++b)
#pragma unroll
            for (int m = 0; m < 4; ++m)
#pragma unroll
                for (int n = 0; n < 2; ++n) acc[a][b][m][n] = (f32x4){0.f, 0.f, 0.f, 0.f};
    bf16x8 At[4][2], B0[2][2], B1[2][2];
    const char* cA = (const char*)g.A + (size_t)cur.pm * tstep; const char* cB = (const char*)g.Bt + (size_t)cur.pn * tstep;
    S.a_ready(cur);
    if constexpr (SP2) {
        PG8_STAGE(PG8_SB(0, 0), cB, voffB); PG8_STAGE(PG8_SB(0, 1), cB + hstep, voffB); PG8_STAGE(PG8_SA(0, 0), cA, voffA); PG8_STAGE(PG8_SA(0, 1), cA + hstep, voffA);
        if (wr == 1) PG8_BAR;
        PG8_WAIT_V(2); PG8_BAR;
        PG8_STAGE(PG8_SB(1, 0), cB + kstep, voffB); PG8_STAGE(PG8_SA(1, 0), cA + kstep, voffA); PG8_STAGE(PG8_SB(1, 1), cB + hstep + kstep, voffB);
        PG8_WAIT_V(6); PG8_BAR;
    } else {
        PG8_STAGE(PG8_SB(0, 0), cB, voffB); PG8_STAGE(PG8_SA(0, 0), cA, voffA); PG8_STAGE(PG8_SB(0, 1), cB + hstep, voffB); PG8_STAGE(PG8_SA(0, 1), cA + hstep, voffA);
        if (wr == 1) PG8_BAR;
        PG8_WAIT_V(4); PG8_BAR;
        PG8_STAGE(PG8_SB(1, 0), cB + kstep, voffB); PG8_STAGE(PG8_SA(1, 0), cA + kstep, voffA); PG8_STAGE(PG8_SB(1, 1), cB + hstep + kstep, voffB);
        PG8_WAIT_V(6); PG8_BAR;
    }
    for (;;) {
        const bool has_next = S.next(ui + 1, nxt);
        const char* nA = has_next ? (const char*)g.A + (size_t)nxt.pm * tstep : cA; const char* nB = has_next ? (const char*)g.Bt + (size_t)nxt.pn * tstep : cB;
        for (int t = 0; t < nt; t += 2) {
            const bool last = (t == nt - 2);
            const char* a1 = cA + (size_t)(t + 1) * kstep;
            const char* a2 = last ? nA : cA + (size_t)(t + 2) * kstep; const char* b2 = last ? nB : cB + (size_t)(t + 2) * kstep;
            const char* a3 = a2 + kstep; const char* b3 = b2 + kstep;
            if (last && has_next) S.a_ready(nxt);
            if constexpr (Epi::HAS_MID) { if (Epi::is_mid(t)) E.mid(acc, cur, t, wr, wc, fr, fq); }
            if constexpr (SP2) {
            PG8_LDB(B0, 0, 0); PG8_LDB(B1, 0, 1); PG8_SCHED; PG8_LDA(At, 0, 0); PG8_STAGE(PG8_SA(1, 1), a1 + hstep, voffA);
            PG8_WAIT_V(8); PG8_WAIT_L(0); PG8_BAR; PG8_MMA(0, 0, At, B0); PG8_MMA(0, 1, At, B1); PG8_BAR; PG8_SCHED;
            PG8_LDA(At, 0, 1); PG8_STAGE(PG8_SB(0, 0), b2, voffB); PG8_STAGE(PG8_SB(0, 1), b2 + hstep, voffB); PG8_STAGE(PG8_SA(0, 0), a2, voffA);
            PG8_WAIT_V(8); PG8_WAIT_L(0); PG8_BAR; PG8_MMA(1, 0, At, B0); PG8_MMA(1, 1, At, B1); PG8_BAR; PG8_SCHED;
            PG8_LDB(B0, 1, 0); PG8_LDB(B1, 1, 1); PG8_SCHED; PG8_LDA(At, 1, 0); PG8_STAGE(PG8_SA(0, 1), a2 + hstep, voffA);
            PG8_WAIT_V(8); PG8_WAIT_L(0); PG8_BAR; PG8_MMA(0, 0, At, B0); PG8_MMA(0, 1, At, B1); PG8_BAR; PG8_SCHED;
            PG8_LDA(At, 1, 1); PG8_STAGE(PG8_SB(1, 0), b3, voffB); PG8_STAGE(PG8_SB(1, 1), b3 + hstep, voffB); PG8_STAGE(PG8_SA(1, 0), a3, voffA);
            PG8_WAIT_V(8); PG8_WAIT_L(0); PG8_BAR; PG8_MMA(1, 0, At, B0); PG8_MMA(1, 1, At, B1); PG8_BAR; PG8_SCHED;
            } else {
            PG8_LDB(B0, 0, 0); PG8_SCHED; PG8_LDA(At, 0, 0); PG8_STAGE(PG8_SA(1, 1), a1 + hstep, voffA);
            PG8_WAIT_L(8); PG8_BAR; PG8_WAIT_L(0); PG8_MMA(0, 0, At, B0); PG8_BAR; PG8_SCHED;
            PG8_LDB(B1, 0, 1); PG8_STAGE(PG8_SB(0, 0), b2, voffB);
            PG8_BAR; PG8_WAIT_L(0); PG8_MMA(0, 1, At, B1); PG8_BAR;
            PG8_LDA(At, 0, 1); PG8_STAGE(PG8_SA(0, 0), a2, voffA);
            PG8_BAR; PG8_WAIT_L(0); PG8_MMA(1, 0, At, B0); PG8_BAR; PG8_SCHED;
            PG8_STAGE(PG8_SB(0, 1), b2 + hstep, voffB);
            PG8_WAIT_V(6); PG8_BAR; PG8_MMA(1, 1, At, B1); PG8_BAR;
            PG8_LDB(B0, 1, 0); PG8_SCHED; PG8_LDA(At, 1, 0); PG8_STAGE(PG8_SA(0, 1), a2 + hstep, voffA);
            PG8_WAIT_L(8); PG8_BAR; PG8_WAIT_L(0); PG8_MMA(0, 0, At, B0); PG8_BAR; PG8_SCHED;
            PG8_LDB(B1, 1, 1); PG8_STAGE(PG8_SB(1, 0), b3, voffB);
            PG8_BAR; PG8_WAIT_L(0); PG8_MMA(0, 1, At, B1); PG8_BAR;
            PG8_LDA(At, 1, 1); PG8_STAGE(PG8_SA(1, 0), a3, voffA);
            PG8_BAR; PG8_WAIT_L(0); PG8_MMA(1, 0, At, B0); PG8_BAR; PG8_SCHED;
            PG8_STAGE(PG8_SB(1, 1), b3 + hstep, voffB);
            PG8_WAIT_V(6); PG8_BAR; PG8_MMA(1, 1, At, B1); PG8_BAR;
            }
        }
        if constexpr (ALIGN_EPI) { if (wr == 0) PG8_BAR; }
        if constexpr (!Epi::AFTER_DRAIN) { E(acc, cur, wr, wc, fr, fq); S.done(cur); }
        if (!has_next) break;
#pragma unroll
        for (int a = 0; a < 2; ++a)
#pragma unroll
            for (int b = 0; b < 2; ++b)
#pragma unroll
                for (int m = 0; m < 4; ++m)
#pragma unroll
                    for (int n = 0; n < 2; ++n) acc[a][b][m][n] = (f32x4){0.f, 0.f, 0.f, 0.f};
        cur = nxt; cA = nA; cB = nB; ++ui;
        if constexpr (ALIGN_EPI) { if (wr == 1) PG8_BAR; }
    }
    PG8_WAIT_V(0);
    if constexpr (!ALIGN_EPI) { if (wr == 0) PG8_BAR; }
    PG8_BAR;
#undef PG8_SA
#undef PG8_SB
#undef PG8_STAGE
#undef PG8_LDA
#undef PG8_LDB
#undef PG8_MMA
#undef PG8_WAIT_V
#undef PG8_WAIT_L
#undef PG8_BAR
#undef PG8_SCHED
}
}

constexpr int DM = 2048, NB = 4, SEQ = 2048, DEPTH = 4, MTOK = NB * SEQ;
constexpr int MEML = 256, NIN = 8192, NGATE = 6144, DFF = 5632;
constexpr float EPS = 1e-5f;
constexpr float LOG2E = 1.4426950408889634f;
#define QKV_AT(b_, s_, col_) ((size_t)(((((col_) >> 7) * NB + (b_)) * SEQ + (s_))) * 128 + ((col_) & 127))
constexpr int C_QA = 0, C_KA = 1024, C_VA = 2048, C_QB = 3072, C_KB = 4608, C_VB = 6144, C_QC = 7680;

typedef unsigned short bf16;
typedef unsigned v4u __attribute__((ext_vector_type(4)));
typedef unsigned v2u __attribute__((ext_vector_type(2)));
typedef float f32x4 __attribute__((ext_vector_type(4)));
#define LAS __attribute__((address_space(3)))

namespace att {
__device__ __forceinline__ int ltid() { int t = threadIdx.x; asm volatile("" : "+v"(t)); return t; }
using bf16x8 = __attribute__((ext_vector_type(8))) short;
using s16x4  = __attribute__((ext_vector_type(4))) short;
using f32x16 = __attribute__((ext_vector_type(16))) float;
using u32x4  = __attribute__((ext_vector_type(4))) unsigned;
constexpr int NW = 8, QBLK = 32, KVBLK = 64;
constexpr int SHM_V = 16384, SHM_K = 16384;
constexpr int OFF_V = 0, OFF_K = 32768, OFF_WS = 65536, OFF_TAB = 65536 + 2048;
constexpr float THR2 = 11.5f;
#define KSWZ(row, colB) ((row) * 256 + ((colB) ^ (((row) & 7) << 4)))
#define SBAR() __builtin_amdgcn_sched_barrier(0)
__device__ __forceinline__ int crow(int r, int hi) { return (r & 3) + 8 * (r >> 2) + 4 * hi; }
__device__ __forceinline__ unsigned cvtpk(float lo, float hi) { unsigned r; asm volatile("v_cvt_pk_bf16_f32 %0, %1, %2" : "=v"(r) : "v"(lo), "v"(hi)); return r; }
__device__ __forceinline__ bf16x8 ld8(const bf16* p) { return *reinterpret_cast<const bf16x8*>(p); }

__device__ __forceinline__ void partialSM(f32x16& p0, f32x16& p1, float& m_reg, float& mn, float& alpha) {
  float pmax = p0[0];
#pragma unroll
  for (int r = 1; r < 16; ++r) pmax = fmaxf(pmax, p0[r]);
#pragma unroll
  for (int r = 0; r < 16; ++r) pmax = fmaxf(pmax, p1[r]);
  { auto rr = __builtin_amdgcn_permlane32_swap(__float_as_uint(pmax), __float_as_uint(pmax), false, false);
    pmax = fmaxf(__uint_as_float(rr[0]), __uint_as_float(rr[1])); }
  if (__builtin_expect(__all(pmax - m_reg <= THR2), 1)) { mn = m_reg; alpha = 1.f; }
  else { mn = fmaxf(m_reg, pmax); alpha = __builtin_amdgcn_exp2f(m_reg - mn); m_reg = mn; }
#pragma unroll
  for (int r = 0; r < 16; ++r) p0[r] = p0[r] - mn;
#pragma unroll
  for (int r = 0; r < 16; ++r) p1[r] = p1[r] - mn;
#pragma unroll
  for (int r = 0; r < 16; ++r) p0[r] = __builtin_amdgcn_exp2f(p0[r]);
}
__device__ __forceinline__ void finishSM(f32x16& p0, f32x16& p1, float alpha, float& l_reg, bf16x8& pa0, bf16x8& pa1, bf16x8& pa2, bf16x8& pa3) {
#pragma unroll
  for (int r = 0; r < 16; ++r) p1[r] = __builtin_amdgcn_exp2f(p1[r]);
  float ps = 0;
#pragma unroll
  for (int r = 0; r < 16; ++r) ps += p0[r];
#pragma unroll
  for (int r = 0; r < 16; ++r) ps += p1[r];
  { auto rr = __builtin_amdgcn_permlane32_swap(__float_as_uint(ps), __float_as_uint(ps), false, false);
    ps = __uint_as_float(rr[0]) + __uint_as_float(rr[1]); }
  l_reg = l_reg * alpha + ps;
#define PK4(P, BASE, OUT) do { unsigned a0 = cvtpk(P[BASE + 0], P[BASE + 1]), a1 = cvtpk(P[BASE + 2], P[BASE + 3]);   \
    unsigned b0 = cvtpk(P[BASE + 4], P[BASE + 5]), b1 = cvtpk(P[BASE + 6], P[BASE + 7]);                              \
    auto r0 = __builtin_amdgcn_permlane32_swap(a0, b0, false, false); auto r1 = __builtin_amdgcn_permlane32_swap(a1, b1, false, false); \
    u32x4 w = {r0[0], r1[0], r0[1], r1[1]}; OUT = *reinterpret_cast<bf16x8*>(&w); } while (0)
  PK4(p0, 0, pa0); PK4(p0, 8, pa1); PK4(p1, 0, pa2); PK4(p1, 8, pa3);
#undef PK4
}
template <int ND> __device__ __forceinline__ void qkt(f32x16& p0, f32x16& p1, const bf16* Ks, const bf16x8* qr, int doff, int r32, int hi) {
  p0 = f32x16{}; p1 = f32x16{};
#pragma unroll
  for (int d0 = 0; d0 < ND; ++d0) { const int cb = ((doff + d0) * 16 + hi * 8) * 2;
    bf16x8 b0 = *reinterpret_cast<const bf16x8*>((const char*)Ks + KSWZ(r32, cb));
    bf16x8 b1 = *reinterpret_cast<const bf16x8*>((const char*)Ks + KSWZ(32 + r32, cb));
    p0 = __builtin_amdgcn_mfma_f32_32x32x16_bf16(b0, qr[d0], p0, 0, 0, 0);
    p1 = __builtin_amdgcn_mfma_f32_32x32x16_bf16(b1, qr[d0], p1, 0, 0, 0); }
}
__device__ __forceinline__ int v_st(int k, int c) { const int kk = (k & ~0xC) | ((k & 4) << 1) | ((k & 8) >> 1); return ((kk >> 3) * 4 + (c >> 5)) * 512 + ((kk & 7) * 32 + (c & 31)) * 2; }
__device__ __forceinline__ int v_rd_base(int lane) { return ((lane & 3) << 3) | (((lane >> 2) & 3) << 6) | (((lane >> 4) & 1) << 5) | (((lane >> 5) & 1) << 8); }
constexpr int v_rd_off(int d0, int ks, int half) { return d0 * 512 + ks * 4096 + half * 2048; }
template <int OFF> __device__ __forceinline__ s16x4 tr_read(int vb) {
  s16x4 r; asm volatile("ds_read_b64_tr_b16 %0, %1 offset:%2" : "=&v"(r) : "v"(vb), "i"(OFF) : "memory"); return r;
}
template <int D0> __device__ __forceinline__ void pv_one(f32x16& od, int vb, bf16x8 pa0, bf16x8 pa1, bf16x8 pa2, bf16x8 pa3) {
  const s16x4 l0 = tr_read<v_rd_off(D0, 0, 0)>(vb), h0 = tr_read<v_rd_off(D0, 0, 1)>(vb), l1 = tr_read<v_rd_off(D0, 1, 0)>(vb), h1 = tr_read<v_rd_off(D0, 1, 1)>(vb);
  const s16x4 l2 = tr_read<v_rd_off(D0, 2, 0)>(vb), h2 = tr_read<v_rd_off(D0, 2, 1)>(vb), l3 = tr_read<v_rd_off(D0, 3, 0)>(vb), h3 = tr_read<v_rd_off(D0, 3, 1)>(vb);
  asm volatile("s_waitcnt lgkmcnt(0)" ::: "memory"); SBAR();
#define PK(L, H) (bf16x8){L[0], L[1], L[2], L[3], H[0], H[1], H[2], H[3]}
  od = __builtin_amdgcn_mfma_f32_32x32x16_bf16(pa0, PK(l0, h0), od, 0, 0, 0);
  od = __builtin_amdgcn_mfma_f32_32x32x16_bf16(pa1, PK(l1, h1), od, 0, 0, 0);
  od = __builtin_amdgcn_mfma_f32_32x32x16_bf16(pa2, PK(l2, h2), od, 0, 0, 0);
  od = __builtin_amdgcn_mfma_f32_32x32x16_bf16(pa3, PK(l3, h3), od, 0, 0, 0);
#undef PK
}
__device__ __forceinline__ void pv_d0(f32x16* o, int vb, bf16x8 pa0, bf16x8 pa1, bf16x8 pa2, bf16x8 pa3) {
  pv_one<0>(o[0], vb, pa0, pa1, pa2, pa3); pv_one<1>(o[1], vb, pa0, pa1, pa2, pa3); pv_one<2>(o[2], vb, pa0, pa1, pa2, pa3); pv_one<3>(o[3], vb, pa0, pa1, pa2, pa3);
}

__device__ __forceinline__ int rel_bucket(int rel) {
  const int n = rel < 0 ? -rel : rel;
  const int v = n < 8 ? n : (n < 15 ? 8 : (n < 27 ? 9 : (n < 50 ? 10 : (n < 91 ? 11 : (n < 166 ? 12 : (n < 305 ? 13 : (n < 559 ? 14 : 15)))))));
  return (rel > 0 ? 16 : 0) + v;
}

template <class P> __device__ __forceinline__ void attn_unit(P& pol, char* lds) {
  const int tid = ltid(), wid = tid >> 6, lane = tid & 63, r32 = lane & 31, hi = lane >> 5;
  bf16* V_lds = (bf16*)(lds + OFF_V); bf16* K_lds = (bf16*)(lds + OFF_K);
  float* ws = (float*)(lds + OFF_WS) + wid * 64; float* li_l = ws; float* al_l = ws + 32;
  float m_reg = -1e30f, l_reg = 0; f32x16 o[4] = {}; bf16x8 qr[P::ND];
  const bf16* Qw = pol.qptr() + hi * 8;
#pragma unroll
  for (int d0 = 0; d0 < P::ND; ++d0) qr[d0] = ld8(Qw + d0 * 16);
  const int sr = tid >> 4, sc = (tid & 15) * 8, vst0 = v_st(sr, sc), vst1 = v_st(32 + sr, sc);
  const int vb0 = (int)(uintptr_t)V_lds + v_rd_base(lane);
  const int doff = pol.doff();
  struct { bf16x8 vs0, vs1, ks0, ks1; } sr_[1];
#define SLOAD(i, t) do { sr_[i].vs0 = ld8(pol.vrow((t), sr) + sc); sr_[i].vs1 = ld8(pol.vrow((t), 32 + sr) + sc); \
    sr_[i].ks0 = ld8(pol.krow((t), sr) + sc); sr_[i].ks1 = ld8(pol.krow((t), 32 + sr) + sc); } while (0)
#define SWRITE(b, i) do { *(bf16x8*)((char*)V_lds + (b) * SHM_V + vst0) = sr_[i].vs0;          \
    *(bf16x8*)((char*)V_lds + (b) * SHM_V + vst1) = sr_[i].vs1; int kc = sc * 2;               \
    *(bf16x8*)((char*)K_lds + (b) * SHM_K + KSWZ(sr, kc)) = sr_[i].ks0;                       \
    *(bf16x8*)((char*)K_lds + (b) * SHM_K + KSWZ(32 + sr, kc)) = sr_[i].ks1; } while (0)
#define RESC(a) do { if (__any((a) < 1.f)) { if (hi == 0) al_l[r32] = (a); asm volatile("s_waitcnt lgkmcnt(0)" ::: "memory"); \
    _Pragma("unroll") for (int d = 0; d < 4; ++d) _Pragma("unroll") for (int r = 0; r < 16; ++r) o[d][r] *= al_l[crow(r, hi)]; } } while (0)
  s16x4 vA[8], vB[8];
#define VRD8(dst, vb, D0) do { dst[0] = tr_read<v_rd_off(D0, 0, 0)>(vb); dst[1] = tr_read<v_rd_off(D0, 0, 1)>(vb); dst[2] = tr_read<v_rd_off(D0, 1, 0)>(vb); dst[3] = tr_read<v_rd_off(D0, 1, 1)>(vb); \
    dst[4] = tr_read<v_rd_off(D0, 2, 0)>(vb); dst[5] = tr_read<v_rd_off(D0, 2, 1)>(vb); dst[6] = tr_read<v_rd_off(D0, 3, 0)>(vb); dst[7] = tr_read<v_rd_off(D0, 3, 1)>(vb); } while (0)
#define PKV(L, H) (bf16x8){L[0], L[1], L[2], L[3], H[0], H[1], H[2], H[3]}
#define PVM(od, src) do { od = __builtin_amdgcn_mfma_f32_32x32x16_bf16(pa0, PKV(src[0], src[1]), od, 0, 0, 0); od = __builtin_amdgcn_mfma_f32_32x32x16_bf16(pa1, PKV(src[2], src[3]), od, 0, 0, 0); \
    od = __builtin_amdgcn_mfma_f32_32x32x16_bf16(pa2, PKV(src[4], src[5]), od, 0, 0, 0); od = __builtin_amdgcn_mfma_f32_32x32x16_bf16(pa3, PKV(src[6], src[7]), od, 0, 0, 0); } while (0)
#define LW(n) asm volatile("s_waitcnt lgkmcnt(" #n ")" ::: "memory")
#define PVREST(vb) do { SBAR(); VRD8(vB, (vb), 1); LW(8); SBAR(); PVM(o[0], vA); SBAR(); VRD8(vA, (vb), 2); LW(8); SBAR(); PVM(o[1], vB); SBAR(); \
    VRD8(vB, (vb), 3); LW(8); SBAR(); PVM(o[2], vA); SBAR(); LW(0); SBAR(); PVM(o[3], vB); SBAR(); } while (0)
  f32x16 pA0, pA1, pB0, pB1; float mnA, mnB, alA, alB; bf16x8 pa0, pa1, pa2, pa3; constexpr int NT = P::NT;
  SLOAD(0, 0);
  pol.prep(lds);
  asm volatile("s_waitcnt vmcnt(0)" ::: "memory"); SWRITE(0, 0); __syncthreads();
  SLOAD(0, 1);
  qkt<P::ND>(pA0, pA1, K_lds, qr, doff, r32, hi); pol.transform(pA0, pA1, 0); partialSM(pA0, pA1, m_reg, mnA, alA);
  SWRITE(1, 0); __syncthreads();
  for (int j = 1; j + 1 < NT; j += 2) {
    SBAR(); SLOAD(0, j + 1); SBAR();
    qkt<P::ND>(pB0, pB1, (bf16*)((char*)K_lds + SHM_K), qr, doff, r32, hi);
    SBAR(); VRD8(vA, vb0, 0); SBAR();
    finishSM(pA0, pA1, alA, l_reg, pa0, pa1, pa2, pa3);
    PVREST(vb0);
    pol.transform(pB0, pB1, j); partialSM(pB0, pB1, m_reg, mnB, alB);
    __syncthreads(); SWRITE(0, 0);
    RESC(alB); __syncthreads();
    SBAR(); SLOAD(0, j + 2); SBAR();
    qkt<P::ND>(pA0, pA1, K_lds, qr, doff, r32, hi);
    SBAR(); VRD8(vA, vb0 + (int)SHM_V, 0); SBAR();
    finishSM(pB0, pB1, alB, l_reg, pa0, pa1, pa2, pa3);
    PVREST(vb0 + (int)SHM_V);
    pol.transform(pA0, pA1, j + 1); partialSM(pA0, pA1, m_reg, mnA, alA);
    __syncthreads(); SWRITE(1, 0);
    RESC(alA); __syncthreads();
  }
  SBAR(); qkt<P::ND>(pB0, pB1, (bf16*)((char*)K_lds + SHM_K), qr, doff, r32, hi);
  SBAR(); VRD8(vA, vb0, 0); SBAR();
  finishSM(pA0, pA1, alA, l_reg, pa0, pa1, pa2, pa3);
  PVREST(vb0);
  pol.transform(pB0, pB1, NT - 1); partialSM(pB0, pB1, m_reg, mnB, alB);
  RESC(alB);
  SBAR(); VRD8(vA, vb0 + (int)SHM_V, 0); SBAR();
  finishSM(pB0, pB1, alB, l_reg, pa0, pa1, pa2, pa3);
  PVREST(vb0 + (int)SHM_V);
#undef VRD8
#undef PKV
#undef PVM
#undef LW
#undef PVREST
  pol.epilogue(o, m_reg, l_reg, li_l, lds);
#undef SLOAD
#undef SWRITE
#undef RESC
}


#define ATT_STORE_TILE(stg_, VAL, ROWPTR) do { unsigned short* stg__ = (unsigned short*)(stg_); \
    _Pragma("unroll") for (int r = 0; r < 16; ++r) { const int row__ = crow(r, hi); \
      _Pragma("unroll") for (int d = 0; d < 4; ++d) { const float v__ = (VAL); stg__[row__ * 128 + d * 32 + r32] = (unsigned short)(cvtpk(v__, v__) & 0xffffu); } \
      if ((r & 3) == 3) __builtin_amdgcn_sched_barrier(0); } \
    asm volatile("s_waitcnt lgkmcnt(0)" ::: "memory"); \
    const int ln__ = (ltid() & 63); \
    _Pragma("unroll") for (int i = 0; i < 8; ++i) { const int row = 4 * i + (ln__ >> 4); const u32x4 w__ = *(const u32x4*)(stg__ + row * 128 + (ln__ & 15) * 8); \
      *(u32x4*)((ROWPTR) + (ln__ & 15) * 8) = w__; if (i & 1) __builtin_amdgcn_sched_barrier(0); } } while (0)

struct PolA {
  static constexpr int ND = 4, NT = SEQ / KVBLK;
  const bf16* qkv; bf16* obuf; const float* subg; float lam, post;
  int b, h, q0, qg, m, r32, hi; const float* tp0;
  const float* relb_;
  __device__ __forceinline__ void init(const bf16* qkv_, bf16* obuf_, const float* subg_, float lam_, float post_, int b_, int h_, int q0_, const float* relb, char* lds) {
    qkv = qkv_; obuf = obuf_; subg = subg_; lam = lam_; post = post_; b = b_; h = h_; q0 = q0_; relb_ = relb;
    const int tid = ltid(), wid = tid >> 6, lane = tid & 63; qg = wid >> 1; m = wid & 1; r32 = lane & 31; hi = lane >> 5;
    float* tab = (float*)(lds + OFF_TAB);
    const int sq = q0 + 32 * qg + r32;
    tp0 = tab + m * 4096 + (4 * hi - sq + 2047);
  }
  __device__ __forceinline__ void prep(char* lds) const {
    const int tid = ltid(); float* tab = (float*)(lds + OFF_TAB); float* colv = tab + 8192;
    if (tid < 64) colv[tid] = relb_[(tid & 31) * 28 + (tid >> 5) * 8 + h] * LOG2E;
    __syncthreads();
#pragma unroll 4
    for (int i = tid; i < 2 * 4096; i += 512) { const int mm = i >> 12, rel = (i & 4095) - 2047; tab[i] = colv[mm * 32 + rel_bucket(rel)]; }
  }
  __device__ __forceinline__ const bf16* qptr() const { return qkv + QKV_AT(b, q0 + 32 * qg + r32, C_QA + h * 128 + m * 64); }
  __device__ __forceinline__ const bf16* krow(int t, int row) const { return qkv + QKV_AT(b, 64 * t + row, C_KA + h * 128); }
  __device__ __forceinline__ const bf16* vrow(int t, int row) const { return qkv + QKV_AT(b, 64 * t + row, C_VA + h * 128); }
  __device__ __forceinline__ int doff() const { return 4 * m; }
  __device__ __forceinline__ void transform(f32x16& p0, f32x16& p1, int t) const {
    constexpr float C = 0.125f * LOG2E; const float* tp = tp0 + 64 * t;
#pragma unroll
    for (int r = 0; r < 16; ++r) { p0[r] = fmaf(p0[r], C, tp[(r & 3) + 8 * (r >> 2)]); p1[r] = fmaf(p1[r], C, tp[32 + (r & 3) + 8 * (r >> 2)]); }
  }
  __device__ __forceinline__ void epilogue(f32x16* o, float m_reg, float l_reg, float* li_l, char* lds) const {
    if (hi == 0) li_l[r32] = l_reg; asm volatile("s_waitcnt lgkmcnt(0)" ::: "memory");
    const float sc = m ? lam : 1.0f;
#pragma unroll
    for (int r = 0; r < 16; ++r) { const float rl = __builtin_amdgcn_rcpf(li_l[crow(r, hi)]) * sc;
#pragma unroll
      for (int d = 0; d < 4; ++d) o[d][r] *= rl; }
    __syncthreads();
    float* X = (float*)lds; const int lane = ltid() & 63;
    if (m == 1) {
#pragma unroll
      for (int d = 0; d < 4; ++d)
#pragma unroll
        for (int r = 0; r < 16; ++r) X[((qg * 4 + d) * 16 + r) * 64 + lane] = o[d][r];
    }
    __syncthreads();
    if (m == 0) {
      float ss[16];
#pragma unroll
      for (int r = 0; r < 16; ++r) { float s = 0.f;
#pragma unroll
        for (int d = 0; d < 4; ++d) { o[d][r] -= X[((qg * 4 + d) * 16 + r) * 64 + lane]; s += o[d][r] * o[d][r]; }
        ss[r] = s; }
#pragma unroll
      for (int off = 1; off < 32; off <<= 1)
#pragma unroll
        for (int r = 0; r < 16; ++r) ss[r] += __shfl_xor(ss[r], off);
      float gsub[4]; unsigned pbits = __float_as_uint(post); asm volatile("" : "+s"(pbits));
      const float oscale = 1.0f - __uint_as_float(pbits);
#pragma unroll
      for (int d = 0; d < 4; ++d) gsub[d] = subg[d * 32 + r32] * oscale;
      float rn[16];
#pragma unroll
      for (int r = 0; r < 16; ++r) rn[r] = __builtin_amdgcn_rsqf(ss[r] * (1.0f / 128.0f) + EPS);
      ATT_STORE_TILE(lds + OFF_TAB + qg * 8192, o[d][r] * rn[r] * gsub[d], obuf + (size_t)(b * SEQ + q0 + 32 * qg + row) * DM + h * 128);
    }
    __syncthreads();
  }
};

struct PolB {
  static constexpr int ND = 8, NT = 6;
  const bf16* qkv; bf16* ob; float* lse;
  int b, g, hb, P0, l2L, dsh, pq, lo, hi_, r32, hi, wid; const float* tp0;
  __device__ __forceinline__ int tok(int p) const { return ((p & ((1 << l2L) - 1)) << dsh) + (p >> l2L); }
  const float* relb_;
  __device__ __forceinline__ void init(const bf16* qkv_, bf16* ob_, float* lse_, int b_, int g_, int hb_, int P0_, const float* relb, char* lds) {
    qkv = qkv_; ob = ob_; lse = lse_; b = b_; g = g_; hb = hb_; P0 = P0_; dsh = 2 * g; l2L = 11 - dsh; relb_ = relb;
    const int tid = ltid(), lane = tid & 63; wid = tid >> 6; r32 = lane & 31; hi = lane >> 5;
    float* tab = (float*)(lds + OFF_TAB);
    pq = P0 + 32 * wid + r32;
    const int cs = (pq >> l2L) << l2L, ce = cs + (1 << l2L) - 1;
    lo = pq - 64 > cs ? pq - 64 : cs; hi_ = pq + 64 < ce ? pq + 64 : ce;
    tp0 = tab + (P0 - 64 + 4 * hi - pq + 320);
  }
  __device__ __forceinline__ void prep(char* lds) const {
    const int tid = ltid(); float* tab = (float*)(lds + OFF_TAB); float* colv = tab + 8192;
    if (tid < 32) colv[tid] = relb_[tid * 28 + 16 + 4 * g + hb] * LOG2E;
    __syncthreads();
    for (int i = tid; i < 640; i += 512) { const int dp = i - 320; tab[i] = (dp >= -64 && dp <= 64) ? colv[rel_bucket(dp * (1 << dsh))] : 0.f; }
  }
  __device__ __forceinline__ const bf16* qptr() const { return qkv + QKV_AT(b, tok(pq), C_QB + g * 512 + hb * 128); }
  __device__ __forceinline__ const bf16* krow(int t, int row) const { int p = P0 - 64 + 64 * t + row; p = p < 0 ? 0 : (p > SEQ - 1 ? SEQ - 1 : p);
    return qkv + QKV_AT(b, tok(p), C_KB + g * 512 + hb * 128); }
  __device__ __forceinline__ const bf16* vrow(int t, int row) const { int p = P0 - 64 + 64 * t + row; p = p < 0 ? 0 : (p > SEQ - 1 ? SEQ - 1 : p);
    return qkv + QKV_AT(b, tok(p), C_VB + g * 512 + hb * 128); }
  __device__ __forceinline__ int doff() const { return 0; }
  __device__ __forceinline__ void transform(f32x16& p0, f32x16& p1, int t) const {
    constexpr float C = 0.08838834764831845f * LOG2E; const float* tp = tp0 + 64 * t; const int kp0 = P0 - 64 + 64 * t + 4 * hi;
#pragma unroll
    for (int r = 0; r < 16; ++r) { const int c = (r & 3) + 8 * (r >> 2); const int kpa = kp0 + c, kpb = kp0 + 32 + c;
      const float va = fmaf(p0[r], C, tp[c]), vb = fmaf(p1[r], C, tp[32 + c]);
      p0[r] = (kpa >= lo && kpa <= hi_) ? va : -1e30f; p1[r] = (kpb >= lo && kpb <= hi_) ? vb : -1e30f; }
  }
  __device__ __forceinline__ void epilogue(f32x16* o, float m_reg, float l_reg, float* li_l, char* lds) const {
    if (hi == 0) { li_l[r32] = l_reg; lse[(size_t)(b * SEQ + tok(pq)) * 4 + hb] = m_reg + __builtin_amdgcn_logf(l_reg); }
    asm volatile("s_waitcnt lgkmcnt(0)" ::: "memory");
    float rl[16];
#pragma unroll
    for (int r = 0; r < 16; ++r) rl[r] = __builtin_amdgcn_rcpf(li_l[crow(r, hi)]);
    __syncthreads();
    ATT_STORE_TILE(lds + wid * 8192, o[d][r] * rl[r], ob + (size_t)(b * SEQ + tok(P0 + 32 * wid + row)) * 512 + hb * 128);
    __syncthreads();
  }
};

struct PolC {
  static constexpr int ND = 8, NT = MEML / KVBLK;
  const bf16* qkv; const bf16* memkv; bf16* obuf; int b, h, q0, r32, hi, wid;
  __device__ __forceinline__ void init(const bf16* qkv_, const bf16* memkv_, bf16* obuf_, int b_, int h_, int q0_) {
    qkv = qkv_; memkv = memkv_; obuf = obuf_; b = b_; h = h_; q0 = q0_; const int tid = ltid(), lane = tid & 63; wid = tid >> 6; r32 = lane & 31; hi = lane >> 5; }
  __device__ __forceinline__ void prep(char*) const {}
  __device__ __forceinline__ const bf16* qptr() const { return qkv + QKV_AT(b, q0 + 32 * wid + r32, C_QC + h * 128); }
  __device__ __forceinline__ const bf16* krow(int t, int row) const { return memkv + (size_t)(b * MEML + 64 * t + row) * 4096 + h * 128; }
  __device__ __forceinline__ const bf16* vrow(int t, int row) const { return memkv + (size_t)(b * MEML + 64 * t + row) * 4096 + 512 + h * 128; }
  __device__ __forceinline__ int doff() const { return 0; }
  __device__ __forceinline__ void transform(f32x16& p0, f32x16& p1, int) const {
    constexpr float C = 0.08838834764831845f * LOG2E;
#pragma unroll
    for (int r = 0; r < 16; ++r) { p0[r] *= C; p1[r] *= C; }
  }
  __device__ __forceinline__ void epilogue(f32x16* o, float m_reg, float l_reg, float* li_l, char* lds) const {
    if (hi == 0) li_l[r32] = l_reg; asm volatile("s_waitcnt lgkmcnt(0)" ::: "memory");
    float rl[16];
#pragma unroll
    for (int r = 0; r < 16; ++r) rl[r] = __builtin_amdgcn_rcpf(li_l[crow(r, hi)]);
    __syncthreads();
    ATT_STORE_TILE(lds + wid * 8192, o[d][r] * rl[r], obuf + (size_t)(b * SEQ + q0 + 32 * wid + row) * DM + 1536 + h * 128);
    __syncthreads();
  }
};
#undef SBAR
}

constexpr size_t MiB = 1u << 20;
constexpr size_t WS_CTL = 0, CTL_ZERO_BYTES = 2 * MiB;
constexpr size_t WS_X    = 2 * MiB;
constexpr size_t WS_H    = WS_X + 64 * MiB;
constexpr size_t WS_QKV  = WS_H + 32 * MiB;
constexpr size_t WS_HID  = WS_QKV;
constexpr size_t WS_GATE = WS_QKV + 128 * MiB;
constexpr size_t WS_OBUF = WS_GATE + 96 * MiB;
constexpr size_t WS_MRG  = WS_OBUF + 32 * MiB;
constexpr size_t WS_OB3  = WS_MRG + 32 * MiB;
constexpr size_t WS_LSE  = WS_OB3 + 48 * MiB;
constexpr size_t WS_MEMN = WS_LSE + 1 * MiB;
constexpr size_t WS_MEMKV= WS_MEMN + 4 * MiB;
constexpr size_t WS_WMEM = WS_MEMKV + 8 * MiB;
constexpr size_t WS_WIN  = WS_WMEM + 16 * MiB;
constexpr size_t WS_WPRJ = WS_WIN + 56 * MiB;
constexpr size_t WS_WOUT = WS_WPRJ + 8 * MiB;
constexpr size_t WS_WFF  = WS_WOUT + 8 * MiB;
constexpr size_t WS_WDN  = WS_WFF + 44 * MiB;
constexpr size_t WS_END  = WS_WDN + 22 * MiB;
constexpr int CW_BAR = 4096;

constexpr int RING_BYTES = 131072, LDSCTL_OFF = RING_BYTES, MISC_OFF = LDSCTL_OFF + 320, LDS_BYTES = 147456;
constexpr int NWAVES = 8;

#define LDS_WAIT() asm volatile("s_waitcnt lgkmcnt(0)" ::: "memory")
#define VM_WAIT() asm volatile("s_waitcnt vmcnt(0)" ::: "memory")

#define XB_TMO      128
#define XB_XCNT(j)  (256  + 64 * (j))
#define XB_XSUB(j)  (1280 + 64 * (j))
#define XB_XGEN(j)  (2304 + 64 * (j))
#define XB_TOP      3328
#define XB_TOPGEN   3392
#define XCD_BAR_WORDS 3456
#define XB_SPIN_CAP (1u << 18)
__device__ __forceinline__ unsigned xb_ld(unsigned* p)              { return __hip_atomic_load(p, __ATOMIC_RELAXED, __HIP_MEMORY_SCOPE_AGENT); }
__device__ __forceinline__ unsigned xb_add(unsigned* p, unsigned v) { return __hip_atomic_fetch_add(p, v, __ATOMIC_RELAXED, __HIP_MEMORY_SCOPE_AGENT); }
__device__ __forceinline__ unsigned xb_xcc_id() { return (unsigned)__builtin_amdgcn_s_getreg((3 << 11) | 20) & 0xFu; }
#define XB_SPIN(cond, bar) do { unsigned _sp = 0; while (cond) { __builtin_amdgcn_s_sleep(1); \
    if ((++_sp & 255u) == 0u) { if (xb_ld(&(bar)[XB_TMO])) break; if (_sp > XB_SPIN_CAP) { atomicAdd(&(bar)[XB_TMO], 1u); break; } } } } while (0)
struct XcdBarrier { unsigned* bar; unsigned x; volatile LAS unsigned* st; };
__device__ __forceinline__ XcdBarrier xcd_barrier_post(unsigned* bar, volatile LAS unsigned* st) {
    XcdBarrier b; b.bar = bar; b.x = xb_xcc_id(); b.st = st;
    if (threadIdx.x == 0) (void)xb_add(&bar[XB_XCNT(b.x)], 1u);
    return b;
}
__device__ __forceinline__ void xcd_barrier_complete(unsigned* bar, unsigned x, unsigned& nloc, unsigned& nx) {
    const unsigned G = gridDim.x * gridDim.y * gridDim.z;
    unsigned sum, cnt, mine, sp = 0u;
    for (;;) {
        sum = 0u; cnt = 0u; mine = 0u;
#pragma unroll
        for (unsigned j = 0; j < 16; ++j) { const unsigned c = xb_ld(&bar[XB_XCNT(j)]); sum += c; cnt += (c > 0u) ? 1u : 0u; mine = (j == x) ? c : mine; }
        if (sum == G) break;
        __builtin_amdgcn_s_sleep(1);
        if ((++sp & 255u) == 0u) { if (xb_ld(&bar[XB_TMO])) break; if (sp > XB_SPIN_CAP) { atomicAdd(&bar[XB_TMO], 1u); break; } }
    }
    nloc = mine > 0u ? mine : 1u; nx = cnt > 0u ? cnt : 1u;
}
__device__ __forceinline__ void xcd_barrier(const XcdBarrier& b) {
    asm volatile("s_waitcnt vmcnt(0)" ::: "memory");
    __syncthreads();
    if (threadIdx.x == 0) {
        unsigned* bar = b.bar;
        __builtin_amdgcn_s_waitcnt(0);
        unsigned nloc = b.st[0], nx = b.st[1];
        if (nloc == 0u) { xcd_barrier_complete(bar, b.x, nloc, nx); b.st[0] = nloc; b.st[1] = nx; }
        const unsigned old = xb_add(&bar[XB_XSUB(b.x)], 1u);
        const unsigned gen = old / nloc;
        if (old + 1u == (gen + 1u) * nloc) {
            __builtin_amdgcn_fence(__ATOMIC_RELEASE, "agent");
            asm volatile("s_waitcnt vmcnt(0)" ::: "memory");
            const unsigned og = xb_add(&bar[XB_TOP], 1u);
            const unsigned tg = og / nx;
            if (og + 1u == (tg + 1u) * nx) xb_add(&bar[XB_TOPGEN], 1u);
            else XB_SPIN(xb_ld(&bar[XB_TOPGEN]) == tg, bar);
            __builtin_amdgcn_fence(__ATOMIC_ACQUIRE, "agent");
            xb_add(&bar[XB_XGEN(b.x)], 1u);
            asm volatile("s_waitcnt vmcnt(0)" ::: "memory");
        } else {
            XB_SPIN(xb_ld(&bar[XB_XGEN(b.x)]) == gen, bar);
            __builtin_amdgcn_fence(__ATOMIC_ACQUIRE, "agent");
            asm volatile("s_waitcnt vmcnt(0)" ::: "memory");
        }
    }
    __syncthreads();
}

__device__ __forceinline__ float wave_sum(float v) {
#pragma unroll
    for (int o = 1; o < 64; o <<= 1) v += __shfl_xor(v, o);
    return v;
}
__device__ __forceinline__ unsigned pkbf(float lo, float hi) { return pg8::cvt_pk_bf16(lo, hi); }

__device__ __forceinline__ void rms_row_bf16(const float* xrow, const float* gain, bf16* orow, int lane) {
    const f32x4* xr = (const f32x4*)xrow + lane; const f32x4* gr = (const f32x4*)gain + lane;
    f32x4 v[8]; float s = 0.f;
#pragma unroll
    for (int j = 0; j < 8; ++j) { v[j] = xr[64 * j]; s += (v[j].x * v[j].x + v[j].y * v[j].y) + (v[j].z * v[j].z + v[j].w * v[j].w); }
    const float rstd = 1.0f / sqrtf(wave_sum(s) * (1.f / DM) + EPS);
    v2u* o8 = (v2u*)orow + lane;
#pragma unroll
    for (int j = 0; j < 8; ++j) { const f32x4 g = gr[64 * j]; v2u w; w.x = pkbf(v[j].x * rstd * g.x, v[j].y * rstd * g.y); w.y = pkbf(v[j].z * rstd * g.z, v[j].w * rstd * g.w); o8[64 * j] = w; }
}
__device__ __forceinline__ void rms_row_f32(const float* xrow, const float* gain, float* orow, int lane) {
    const f32x4* xr = (const f32x4*)xrow + lane; const f32x4* gr = (const f32x4*)gain + lane;
    f32x4 v[8]; float s = 0.f;
#pragma unroll
    for (int j = 0; j < 8; ++j) { v[j] = xr[64 * j]; s += (v[j].x * v[j].x + v[j].y * v[j].y) + (v[j].z * v[j].z + v[j].w * v[j].w); }
    const float rstd = 1.0f / sqrtf(wave_sum(s) * (1.f / DM) + EPS);
    f32x4* o = (f32x4*)orow + lane;
#pragma unroll
    for (int j = 0; j < 8; ++j) { const f32x4 g = gr[64 * j]; o[64 * j] = v[j] * rstd * g; }
}

struct WtDesc { const float* W; const float* gn; bf16* dst; int N, ldk; };
__device__ __forceinline__ void wt_load(f32x4 (&v)[16], float (&gv)[16], const WtDesc& D, int lane) {
    const float* src = D.W + (size_t)(16 * (lane >> 4)) * D.N + 4 * (lane & 15);
#pragma unroll
    for (int i = 0; i < 16; ++i) v[i] = __builtin_nontemporal_load((const f32x4*)(src + (size_t)i * D.N));
    if (D.gn) { const f32x4* g4 = (const f32x4*)(D.gn + 16 * (lane >> 4));
#pragma unroll
        for (int i = 0; i < 4; ++i) { const f32x4 g = g4[i]; gv[4 * i] = g.x; gv[4 * i + 1] = g.y; gv[4 * i + 2] = g.z; gv[4 * i + 3] = g.w; } }
    else {
#pragma unroll
        for (int i = 0; i < 16; ++i) gv[i] = 1.0f; }
}
__device__ __forceinline__ void wt_proc_a(const f32x4 (&v)[16], const float (&gv)[16], LAS unsigned char* T, int lane) {
    LAS unsigned char* tw = T + (4 * (lane & 15)) * 144 + (16 * (lane >> 4)) * 2;
#pragma unroll
    for (int i4 = 0; i4 < 4; ++i4) { const f32x4 a = v[4 * i4] * gv[4 * i4], b = v[4 * i4 + 1] * gv[4 * i4 + 1], c = v[4 * i4 + 2] * gv[4 * i4 + 2], d = v[4 * i4 + 3] * gv[4 * i4 + 3];
#pragma unroll
        for (int cc = 0; cc < 4; ++cc) { v2u w; w.x = pkbf(a[cc], b[cc]); w.y = pkbf(c[cc], d[cc]); *(LAS v2u*)(tw + cc * 144 + i4 * 8) = w; } }
    LDS_WAIT(); asm volatile("" ::: "memory");
}
__device__ __forceinline__ void wt_proc_b(const WtDesc& D, LAS unsigned char* T, int lane) {
    const LAS unsigned char* tr = T + (lane >> 3) * 144 + (lane & 7) * 16;
    bf16* dst = D.dst + (size_t)(lane >> 3) * D.ldk + (lane & 7) * 8;
    v4u w[8];
#pragma unroll
    for (int r = 0; r < 8; ++r) w[r] = *(const LAS v4u*)(tr + r * 8 * 144);
#pragma unroll
    for (int r = 0; r < 8; ++r) __builtin_nontemporal_store(w[r], (v4u*)(dst + (size_t)(8 * r) * D.ldk));
    LDS_WAIT(); asm volatile("" ::: "memory");
}
__device__ __forceinline__ void wt_proc(const f32x4 (&v)[16], const float (&gv)[16], const WtDesc& D, LAS unsigned char* T, int lane) { wt_proc_a(v, gv, T, lane); wt_proc_b(D, T, lane); }
__device__ __forceinline__ void wt_item(const float* W, int N, int k0, int n0, bf16* wt0, int ldk, LAS unsigned char* T, int lane, const float* gain = nullptr) {
    WtDesc D; D.W = W + (size_t)k0 * N + n0; D.gn = gain ? gain + k0 : nullptr; D.dst = wt0; D.N = N; D.ldk = ldk;
    f32x4 v[16]; float gv[16]; wt_load(v, gv, D, lane); wt_proc(v, gv, D, T, lane);
}
constexpr int IT_WIN = (DM / 64) * (NIN / 64), IT_WGATE = (DM / 64) * (NGATE / 64), IT_PA = (1024 / 64) * (DM / 64), IT_PB = (512 / 64) * (DM / 64), IT_PC = IT_PB,
              IT_WOUT = (DM / 64) * (DM / 64), IT_FG = (DM / 64) * (DFF / 64), IT_FU = IT_FG, IT_FD = (DFF / 64) * (DM / 64);
constexpr int IT_E0 = IT_WIN, IT_E1 = IT_E0 + IT_WGATE, IT_E2 = IT_E1 + IT_PA, IT_E3 = IT_E2 + IT_PB, IT_E4 = IT_E3 + IT_PC, IT_E5 = IT_E4 + IT_WOUT, IT_E6 = IT_E5 + IT_FG, IT_E7 = IT_E6 + IT_FU, IT_E8 = IT_E7 + IT_FD;
struct Args {
    const float* in[20]; float* out; unsigned char* ws; int ph_lo, ph_hi, li, pad;
};
constexpr int PH_PRO = 0, PH_MEMKV = 1, PH_L0 = 2, PH_PER_LAYER = 7, PH_FINAL = PH_L0 + DEPTH * PH_PER_LAYER, PH_N = PH_FINAL + 1;
constexpr int CW_QUEUE = 150000;
constexpr int CW_SS = 262144;
static_assert((size_t)CW_SS * 4 + (size_t)9 * MTOK * 8 <= CTL_ZERO_BYTES && CW_BAR + 40 * XCD_BAR_WORDS <= CW_QUEUE, "CTL map");

#define CONV_DECODE(D_, it_, lw_) do { const int ci_ = (it_); const int clw_ = (lw_); \
        const float* W; int K, N, ldk, koff, r, swz; bf16* WT; int rowoff; const float* gn = nullptr; \
        if (ci_ < IT_E0)      { r = ci_;         W = INP(5) + (size_t)clw_ * DM * NIN;    K = DM;   N = NIN;   WT = P_WIN;  ldk = DM;  koff = 0;    rowoff = 0;   swz = -1; gn = INP(4) + clw_ * DM; } \
        else if (ci_ < IT_E1) { r = ci_ - IT_E0; W = INP(9) + (size_t)clw_ * DM * NGATE;  K = DM;   N = NGATE; WT = P_WIN;  ldk = DM;  koff = 0;    rowoff = NIN; swz = -1; gn = INP(4) + clw_ * DM; } \
        else if (ci_ < IT_E2) { r = ci_ - IT_E1; W = INP(11) + (size_t)clw_ * 1024 * DM;  K = 1024; N = DM;    WT = P_WPRJ; ldk = DM;  koff = 0;    rowoff = 0;   swz = -1; } \
        else if (ci_ < IT_E3) { r = ci_ - IT_E2; W = INP(12) + (size_t)clw_ * 512 * DM;   K = 512;  N = DM;    WT = P_WPRJ; ldk = DM;  koff = 1024; rowoff = 0;   swz = -1; } \
        else if (ci_ < IT_E4) { r = ci_ - IT_E3; W = INP(13) + (size_t)clw_ * 512 * DM;   K = 512;  N = DM;    WT = P_WPRJ; ldk = DM;  koff = 1536; rowoff = 0;   swz = -1; } \
        else if (ci_ < IT_E5) { r = ci_ - IT_E4; W = INP(14) + (size_t)clw_ * DM * DM;    K = DM;   N = DM;    WT = P_WOUT; ldk = DM;  koff = 0;    rowoff = 0;   swz = -1; } \
        else if (ci_ < IT_E6) { r = ci_ - IT_E5; W = INP(16) + (size_t)clw_ * DM * DFF;   K = DM;   N = DFF;   WT = P_WFF;  ldk = DM;  koff = 0;    rowoff = 0;   swz = 0; gn = INP(15) + clw_ * DM; } \
        else if (ci_ < IT_E7) { r = ci_ - IT_E6; W = INP(17) + (size_t)clw_ * DM * DFF;   K = DM;   N = DFF;   WT = P_WFF;  ldk = DM;  koff = 0;    rowoff = 0;   swz = 1; gn = INP(15) + clw_ * DM; } \
        else                 { r = ci_ - IT_E7; W = INP(18) + (size_t)clw_ * DFF * DM;   K = DFF;  N = DM;    WT = P_WDN;  ldk = DFF; koff = 0;    rowoff = 0;   swz = -1; } \
        const int nnb = N >> 6, kb = r / nnb, nb = r - kb * nnb, n0 = nb * 64, k0 = kb * 64;     \
        const int drow = swz < 0 ? (rowoff + n0) : ((n0 >> 7) * 256 + swz * 128 + (n0 & 127)); \
        (D_).W = W + (size_t)k0 * N + n0; (D_).gn = gn ? gn + k0 : nullptr; (D_).dst = WT + (size_t)drow * ldk + koff + k0; (D_).N = N; (D_).ldk = ldk; } while (0)
#define CONV_ITEM(it_, lw_) do { WtDesc D_; CONV_DECODE(D_, it_, lw_); f32x4 v_[16]; float g_[16]; wt_load(v_, g_, D_, lane); wt_proc(v_, g_, D_, Twave, lane); } while (0)

__global__ void __launch_bounds__(NWAVES * 64, 2) trunk_fwd(Args args) {
    extern __shared__ __attribute__((aligned(16))) unsigned char lds[];
    LAS unsigned char* ldsl = (LAS unsigned char*)lds;
    volatile LAS unsigned* MISC = (volatile LAS unsigned*)(ldsl + MISC_OFF);
    const int tid = threadIdx.x, wave = __builtin_amdgcn_readfirstlane(tid >> 6);
#define LANE() (att::ltid() & 63)
    const int G = gridDim.x; const int bx = blockIdx.x; const int vcu = (G % 8 == 0) ? (bx % 8) * (G / 8) + bx / 8 : bx;
    const int gw = vcu * NWAVES + wave, NGW = G * NWAVES;
    typedef const __attribute__((address_space(4))) Args* KArgs;
    unsigned long long ka_bits = (unsigned long long)__builtin_amdgcn_kernarg_segment_ptr();
#define KA() ({ asm volatile("" : "+s"(ka_bits)); (KArgs)ka_bits; })
#define WSP(off) ((unsigned char*)KA()->ws + (off))
#define INP(k) (KA()->in[k])
    unsigned* ctl = (unsigned*)WSP(WS_CTL);
    for (int u = tid; u < (LDS_BYTES - LDSCTL_OFF) / 4; u += NWAVES * 64) ((LAS unsigned*)(ldsl + LDSCTL_OFF))[u] = 0u;
    __syncthreads();
    XcdBarrier bar = xcd_barrier_post(ctl + CW_BAR + KA()->li * XCD_BAR_WORDS, MISC + 8);
    const int lo = KA()->ph_lo, hi = KA()->ph_hi;
#define IN(k) (lo <= (k) && (k) < hi)
#define SEAM(k) do { if (IN(k) && IN((k) + 1)) xcd_barrier(bar); } while (0)

#define P_X      ((float*)WSP(WS_X))
#define P_XB     ((bf16*)WSP(WS_H))
#define P_QKV    ((bf16*)WSP(WS_QKV))
#define P_HID    ((bf16*)WSP(WS_HID))
#define P_GATE   ((bf16*)WSP(WS_GATE))
#define P_OBUF   ((bf16*)WSP(WS_OBUF))
#define P_MRG    ((bf16*)WSP(WS_MRG))
#define P_OB3    ((bf16*)WSP(WS_OB3))
#define P_LSE    ((float*)WSP(WS_LSE))
#define P_MEMN   ((bf16*)WSP(WS_MEMN))
#define P_MEMKV  ((bf16*)WSP(WS_MEMKV))
#define P_WMEM   ((bf16*)WSP(WS_WMEM))
#define P_WIN    ((bf16*)WSP(WS_WIN))
#define P_WPRJ   ((bf16*)WSP(WS_WPRJ))
#define P_WOUT   ((bf16*)WSP(WS_WOUT))
#define P_WFF    ((bf16*)WSP(WS_WFF))
#define P_WDN    ((bf16*)WSP(WS_WDN))
#define P_SS(i)  ((unsigned long long*)((unsigned*)WSP(WS_CTL) + CW_SS) + (i) * MTOK)
    LAS unsigned char* Twave = ldsl + wave * 9216;

    if (IN(PH_PRO)) {
        const int lane = LANE();
        { const float* w_mem_kv = INP(8); bf16* WMEM = P_WMEM;
          for (int it = gw; it < DEPTH * (DM / 64) * (1024 / 64); it += NGW) { const int l = it >> 9, r = it & 511, kb = r >> 4, nb = r & 15;
              wt_item(w_mem_kv + (size_t)l * DM * 1024, 1024, kb * 64, nb * 64, WMEM + (size_t)(l * 1024 + nb * 64) * DM + kb * 64, DM, Twave, lane); } }
        { const float* mem = INP(1); const float* mem_norm = INP(3); bf16* MEMN = P_MEMN;
          for (int m = gw; m < NB * MEML; m += NGW) rms_row_bf16(mem + (size_t)m * DM, mem_norm, MEMN + (size_t)m * DM, lane); }
    }
    SEAM(PH_PRO);
    if (IN(PH_MEMKV)) {
        constexpr int NMU = (NB * MEML / 256) * (4096 / 256);
        { pg8::Gemm g{P_MEMN, P_WMEM, NB * MEML, 4096, DM}; pg8::StaticOrder S; S.init(NB * MEML, 4096, G, bx);
            pg8::EpiPlain E{P_MEMKV, 4096};
            pg8::gemm_phase<pg8::EpiPlain, pg8::StaticOrder, true, true>(ldsl, g, S, E); }
        const bool split = G > 2 * NMU;
        if (!split || bx >= NMU) {
            const int lane = LANE();
            const int tgw = split ? (bx - NMU) * NWAVES + wave : bx * NWAVES + wave, tngw = split ? (G - NMU) * NWAVES : G * NWAVES;
            for (int it = tgw; it < IT_E1; it += tngw) CONV_ITEM(it, 0);
            { const float* xin = INP(0); bf16* XB = P_XB; unsigned long long* ss0 = P_SS(0);
              for (int m = tgw; m < MTOK; m += tngw) { const f32x4* xr = (const f32x4*)(xin + (size_t)m * DM) + lane; v2u* o8 = (v2u*)(XB + (size_t)m * DM) + lane; float sq = 0.f;
#pragma unroll
                  for (int j = 0; j < 8; ++j) { const f32x4 v = xr[64 * j]; v2u w; w.x = pkbf(v.x, v.y); w.y = pkbf(v.z, v.w); o8[64 * j] = w;
                      const float r0 = pg8::bf_lo(w.x), r1 = pg8::bf_hi(w.x), r2 = pg8::bf_lo(w.y), r3 = pg8::bf_hi(w.y); sq += (r0 * r0 + r1 * r1) + (r2 * r2 + r3 * r3); }
                  sq = wave_sum(sq); if (lane == 0) ss0[m] = (unsigned long long)(sq * 1048576.0f + 0.5f); } }
        }
    }
    SEAM(PH_MEMKV);

    for (int l = 0; l < DEPTH; ++l) {
        const int pb = PH_L0 + l * PH_PER_LAYER;
        if (IN(pb + 0)) {
            pg8::Gemm g{P_XB, P_WIN, MTOK, NIN + NGATE, DM}; pg8::StaticOrder S; S.init(MTOK, NIN + NGATE, G, bx);
            pg8::EpiInGate E{P_QKV, P_GATE, INP(10) + (size_t)l * NGATE, P_SS(2 * l)};
            pg8::gemm_phase<pg8::EpiInGate, pg8::StaticOrder, true, true>(ldsl, g, S, E);
        }
        SEAM(pb + 0);
        if (IN(pb + 1)) {
            float lam, post;
            { const int lane = LANE(); const float* dl = INP(6) + (size_t)l * 256; const float s1 = wave_sum(dl[lane] * dl[64 + lane]), s2 = wave_sum(dl[128 + lane] * dl[192 + lane]);
              const float lam_init = 0.8f - 0.6f * expf(-0.3f * (float)l); const float lamv = expf(s1) - expf(s2) + lam_init;
              lam = __uint_as_float(__builtin_amdgcn_readfirstlane(__float_as_uint(lamv))); post = __uint_as_float(__builtin_amdgcn_readfirstlane(__float_as_uint(lam_init))); }
            constexpr int NCH = 170, IPC = 104, NLOC = IT_E8 - IT_E1;
            static_assert(NCH * IPC >= IT_E8, "conversion chunks cover every item");
            const int TI = NLOC + (l + 1 < DEPTH ? IT_E1 : 0);
            const int qx = bx & 7, ncx = (NCH - qx + 7) >> 3, QR = 64 + ncx;
            unsigned* qhead = ctl + CW_QUEUE + 64 * (l * 8 + qx);
            for (;;) {
                __syncthreads();
                if (tid == 0) MISC[16] = __hip_atomic_fetch_add(qhead, 1u, __ATOMIC_RELAXED, __HIP_MEMORY_SCOPE_AGENT);
                __syncthreads();
                const int u = __builtin_amdgcn_readfirstlane((int)MISC[16]);
                if (u >= QR + 64) break;
                if (u < QR) {
                    if ((u & 3) == 0 && (u >> 2) < ncx) {
                        const int c = qx + 8 * (u >> 2); const int lane = LANE();
                        int j = c * IPC + wave; const int jend = (c + 1) * IPC < TI ? (c + 1) * IPC : TI;
#define JDEC(D, jj) do { const int jj_ = (jj); if (jj_ < NLOC) CONV_DECODE(D, IT_E1 + jj_, l); else CONV_DECODE(D, jj_ - NLOC, l + 1); } while (0)
                        if (j < jend) {
                            WtDesc D; f32x4 v[16]; float gv[16];
                            JDEC(D, j); wt_load(v, gv, D, lane);
                            for (;;) {
                                const int j1 = j + 8; const bool h1 = j1 < jend;
                                WtDesc Dn; if (h1) JDEC(Dn, j1);
                                wt_proc_a(v, gv, Twave, lane);
                                if (h1) wt_load(v, gv, Dn, lane);
                                wt_proc_b(D, Twave, lane);
                                if (!h1) break;
                                D = Dn; j = j1;
                            }
                        }
#undef JDEC
                        LDS_WAIT();
                    } else {
                        const int cb = (u >> 2) + 1, al = u - (cb < ncx ? cb : ncx), au = (qx * 4 + (al >> 4)) * 16 + (al & 15);
                        const int chunk = au & 15, h = (au >> 4) & 7, b = au >> 7;
                        att::PolA P; P.init(P_QKV, P_OBUF, INP(7) + l * 128, lam, post, b, h, chunk * 128, INP(2), (char*)lds);
                        att::attn_unit<att::PolA>(P, (char*)lds);
                    }
                } else if (u < QR + 48) { {
                    const int su = qx * 48 + (u - QR); const int g_ = su % 3, r = su / 3, chunk = r & 7, hb = (r >> 3) & 3, b = r >> 5;
                    att::PolB P; P.init(P_QKV, P_OB3 + (size_t)g_ * MTOK * 512, P_LSE + (size_t)g_ * MTOK * 4, b, g_, hb, chunk * 256, INP(2), (char*)lds);
                    att::attn_unit<att::PolB>(P, (char*)lds); }
                } else { {
                    const int r = qx * 16 + (u - QR - 48), chunk = r & 7, h = (r >> 3) & 3, b = r >> 5;
                    att::PolC P; P.init(P_QKV, P_MEMKV + l * 1024, P_OBUF, b, h, chunk * 256);
                    att::attn_unit<att::PolC>(P, (char*)lds); }
                }
            }
        }
        SEAM(pb + 1);
        if (IN(pb + 2)) {
            const int lane = LANE();
            const float* LSE = P_LSE; const bf16* OB3 = P_OB3; bf16* OBUF = P_OBUF;
            for (int m = gw; m < MTOK; m += NGW) {
                const int hb = lane >> 4;
                const float l0 = LSE[(size_t)m * 4 + hb], l1 = LSE[(size_t)(MTOK + m) * 4 + hb], l2 = LSE[(size_t)(2 * MTOK + m) * 4 + hb];
                const float mx = fmaxf(l0, fmaxf(l1, l2));
                float a0 = __builtin_amdgcn_exp2f(l0 - mx), a1 = __builtin_amdgcn_exp2f(l1 - mx), a2 = __builtin_amdgcn_exp2f(l2 - mx);
                const float inv = 1.0f / (a0 + a1 + a2); a0 *= inv; a1 *= inv; a2 *= inv;
                const bf16* p0 = OB3 + (size_t)m * 512 + lane * 8;
                const v4u u = *(const v4u*)p0, v = *(const v4u*)(p0 + (size_t)MTOK * 512), w3 = *(const v4u*)(p0 + (size_t)2 * MTOK * 512);
#define CMB(x_) (pg8::bf_lo(u.x_) * a0 + pg8::bf_lo(v.x_) * a1 + pg8::bf_lo(w3.x_) * a2), (pg8::bf_hi(u.x_) * a0 + pg8::bf_hi(v.x_) * a1 + pg8::bf_hi(w3.x_) * a2)
                v4u w; w.x = pkbf(CMB(x)); w.y = pkbf(CMB(y)); w.z = pkbf(CMB(z)); w.w = pkbf(CMB(w));
#undef CMB
                *(v4u*)(OBUF + (size_t)m * DM + 1024 + lane * 8) = w;
            }
        }
        SEAM(pb + 2);
        if (IN(pb + 3)) {
            pg8::Gemm g{P_OBUF, P_WPRJ, MTOK, DM, DM}; pg8::StaticOrder S; S.init(MTOK, DM, G, bx);
            pg8::EpiProj E{P_GATE, P_MRG};
            pg8::gemm_phase<pg8::EpiProj, pg8::StaticOrder, true, true>(ldsl, g, S, E);
        }
        SEAM(pb + 3);
        if (IN(pb + 4)) {
            pg8::Gemm g{P_MRG, P_WOUT, MTOK, DM, DM}; pg8::StaticOrder S; S.init(MTOK, DM, G, bx);
            pg8::EpiResid E{(l == 0) ? INP(0) : (const float*)nullptr, P_XB, P_SS(2 * l + 1)};
            pg8::gemm_phase<pg8::EpiResid, pg8::StaticOrder, true, true>(ldsl, g, S, E);
        }
        SEAM(pb + 4);
        if (IN(pb + 5)) {
            pg8::Gemm g{P_XB, P_WFF, MTOK, 2 * DFF, DM}; pg8::StaticOrder S; S.init(MTOK, 2 * DFF, G, bx);
            pg8::EpiSwiGLU E{P_HID, P_SS(2 * l + 1)};
            pg8::gemm_phase<pg8::EpiSwiGLU, pg8::StaticOrder, true, true>(ldsl, g, S, E);
        }
        SEAM(pb + 5);
        if (IN(pb + 6)) {
            pg8::Gemm g{P_HID, P_WDN, MTOK, DM, DFF}; pg8::StaticOrder S; S.init(MTOK, DM, G, bx);
            pg8::EpiResid E{nullptr, P_XB, P_SS(2 * l + 2)};
            pg8::gemm_phase<pg8::EpiResid, pg8::StaticOrder, true, true>(ldsl, g, S, E);
        }
        SEAM(pb + 6);
    }
    if (IN(PH_FINAL)) {
        const int lane = LANE();
        const bf16* Xp = P_XB; const float* gn = INP(19); float* outp = KA()->out; const unsigned long long* ss = P_SS(8);
        for (int m = gw; m < MTOK; m += NGW) { const float rstd = 1.0f / sqrtf((float)ss[m] * (1.f / (DM * 1048576.0f)) + EPS);
            const v2u* xr = (const v2u*)(Xp + (size_t)m * DM) + lane; const f32x4* gr = (const f32x4*)gn + lane; f32x4* o = (f32x4*)(outp + (size_t)m * DM) + lane;
#pragma unroll
            for (int j = 0; j < 8; ++j) { const v2u p = xr[64 * j]; const f32x4 x = (f32x4){pg8::bf_lo(p.x), pg8::bf_hi(p.x), pg8::bf_lo(p.y), pg8::bf_hi(p.y)}; o[64 * j] = x * rstd * gr[64 * j]; } }
    }
#undef IN
#undef SEAM
}

extern "C" void kernel_launch(void* const* d_in, const int* in_sizes, int n_in, void* d_out, int out_size, void* d_ws, size_t ws_size, hipStream_t stream) {
    static int grid = 0;
    if (grid == 0) {
        if (n_in != 20 || out_size != MTOK * DM || ws_size < WS_END) { fprintf(stderr, "kernel_launch: unexpected shapes: n_in %d out %d ws %zu (need %zu)\n", n_in, out_size, ws_size, (size_t)WS_END); grid = -1; return; }
        int dev = 0, cus = 0, per_cu = 0;
        if (hipGetDevice(&dev) != hipSuccess || hipDeviceGetAttribute(&cus, hipDeviceAttributeMultiprocessorCount, dev) != hipSuccess) { grid = -1; return; }
        if (hipFuncSetAttribute((const void*)trunk_fwd, hipFuncAttributeMaxDynamicSharedMemorySize, LDS_BYTES) != hipSuccess) { fprintf(stderr, "kernel_launch: hipFuncSetAttribute failed\n"); grid = -1; return; }
        if (hipOccupancyMaxActiveBlocksPerMultiprocessor(&per_cu, (const void*)trunk_fwd, NWAVES * 64, LDS_BYTES) != hipSuccess || per_cu < 1)
            fprintf(stderr, "kernel_launch: occupancy query reports %d workgroups per CU\n", per_cu);
        (void)hipGetLastError();
        grid = cus;
    }
    if (grid < 0) return;
    if (hipMemsetAsync((char*)d_ws + WS_CTL, 0, CTL_ZERO_BYTES, stream) != hipSuccess) { fprintf(stderr, "kernel_launch: memset failed\n"); return; }
    Args a{};
    for (int i = 0; i < 20; ++i) a.in[i] = (const float*)d_in[i];
    a.out = (float*)d_out; a.ws = (unsigned char*)d_ws; a.pad = 0;
#if MK_PER_PHASE
    for (int p = 0; p < PH_N; ++p) { a.ph_lo = p; a.ph_hi = p + 1; a.li = p;
        hipLaunchKernelGGL(trunk_fwd, dim3(grid), dim3(NWAVES * 64), LDS_BYTES, stream, a); }
#else
    a.ph_lo = 0; a.ph_hi = PH_N; a.li = 0;
    hipLaunchKernelGGL(trunk_fwd, dim3(grid), dim3(NWAVES * 64), LDS_BYTES, stream, a);
#endif
    const hipError_t le = hipPeekAtLastError();
    if (le != hipSuccess) fprintf(stderr, "kernel_launch: launch failed: %s\n", hipGetErrorName(le));
}
```

```cpp
#include <hip/hip_runtime.h>
#include <cstdio>
#include <cstdint>


#ifndef MK_PER_PHASE
#define MK_PER_PHASE 0
#endif

namespace pg8 {
#define PG8_LAS __attribute__((address_space(3)))
typedef unsigned short bf16_t;
typedef short bf16x8 __attribute__((ext_vector_type(8)));
typedef float f32x4 __attribute__((ext_vector_type(4)));
typedef unsigned u32x4 __attribute__((ext_vector_type(4)));
constexpr int BM = 256, BK = 64, HALF = 128, HTB = HALF * BK * 2, STAGE_BYTES = 8 * HTB, NXCD = 8, WGM = 8;

__host__ __device__ __forceinline__ int lds_byte(int r, int c) { const int st = (r >> 4) * 2 + (c >> 5), rr = r & 15, cc = c & 31, ob = rr * 64 + cc * 2; return st * 1024 + (ob ^ (((ob >> 9) & 1) << 5)); }
__host__ __device__ __forceinline__ void stage_rc(int b, int& R, int& C) { const int st = b / 1024, sb = b % 1024, swz = sb ^ (((sb >> 9) & 1) << 5); R = (st >> 1) * 16 + swz / 64; C = (st & 1) * 32 + (swz % 64) / 2; }
__host__ __device__ __forceinline__ int perm32(int rho) { const int n = rho >> 4, i = rho & 15; return 8 * (i >> 2) + 4 * n + (i & 3); }

struct Unit { int pm, pn; };
struct Gemm { const bf16_t* A; const bf16_t* Bt; int M, N, K; };

struct StaticOrder {
    int nM, nN, nwg, G, c;
    __host__ __device__ void init(int M, int N, int G_, int c_) { nM = M / BM; nN = N / BM; nwg = nM * nN; G = G_; c = c_; }
    __host__ __device__ bool next(int i, Unit& u) const {
        const long L = (long)i * G + c; if (L >= nwg) return false;
        int wgid = (int)L; { const int q = nwg / NXCD, r = nwg % NXCD, xcd = wgid % NXCD, off = wgid / NXCD; wgid = (xcd < r ? xcd * (q + 1) : r * (q + 1) + (xcd - r) * q) + off; }
        const int nig = WGM * nN, gid = wgid / nig, fm = gid * WGM, gsz = (nM - fm) < WGM ? (nM - fm) : WGM;
        u.pm = fm + ((wgid % nig) % gsz); u.pn = (wgid % nig) / gsz; return true;
    }
    __device__ __forceinline__ void a_ready(const Unit&) const {}
    __device__ __forceinline__ void done(const Unit&) const {}
};

__device__ __forceinline__ unsigned cvt_pk_bf16(float lo, float hi) { unsigned r; asm volatile("v_cvt_pk_bf16_f32 %0, %1, %2" : "=v"(r) : "v"(lo), "v"(hi)); return r; }
__device__ __forceinline__ float bf_lo(unsigned w) { return __uint_as_float(w << 16); }
__device__ __forceinline__ float bf_hi(unsigned w) { return __uint_as_float(w & 0xffff0000u); }
__device__ __forceinline__ float sigmoidf_(float v) { return __builtin_amdgcn_rcpf(1.0f + __builtin_amdgcn_exp2f(-1.4426950408889634f * v)); }


struct EpiInGate {
    static constexpr bool PERM = true, AFTER_DRAIN = false, HAS_MID = false;
    bf16_t* qkv; bf16_t* gate; const float* bgate; const unsigned long long* ss;
    __device__ __forceinline__ void operator()(const f32x4 (&acc)[2][2][4][2], const Unit& u, int wr, int wc, int fr, int fq) const {
        const int row0 = u.pm * BM + wr * 64 + fr; int colt = u.pn * BM;
        const bool isg = colt >= 8192;
        if (isg) colt -= 8192;
        const int col0 = colt + wc * 32 + 8 * fq;
        f32x4 bv[2][2];
#pragma unroll
        for (int bj = 0; bj < 2; ++bj)
#pragma unroll
            for (int n = 0; n < 2; ++n) bv[bj][n] = isg ? *(const f32x4*)(bgate + col0 + bj * HALF + 4 * n) : (f32x4){0.f, 0.f, 0.f, 0.f};
        const int bb = (u.pm * BM) >> 11, s0 = (row0 & 2047);
#pragma unroll
        for (int ai = 0; ai < 2; ++ai)
#pragma unroll
            for (int m = 0; m < 4; ++m) {
                const float rs = __builtin_amdgcn_rsqf((float)ss[row0 + ai * HALF + m * 16] * (1.0f / (2048.0f * 1048576.0f)) + 1e-5f);
#pragma unroll
                for (int bj = 0; bj < 2; ++bj) { f32x4 v0 = acc[ai][bj][m][0] * rs + bv[bj][0], v1 = acc[ai][bj][m][1] * rs + bv[bj][1];
                    bf16_t* dst;
                    if (isg) { dst = gate + (size_t)(row0 + ai * HALF + m * 16) * 6144 + col0 + bj * HALF;
#pragma unroll
                        for (int i = 0; i < 4; ++i) { v0[i] = fmaxf(sigmoidf_(v0[i]), 1e-30f); v1[i] = fmaxf(sigmoidf_(v1[i]), 1e-30f); } }
                    else dst = qkv + (size_t)(((((colt >> 7) + bj) * 4 + bb) * 2048) + s0 + ai * HALF + m * 16) * 128 + wc * 32 + 8 * fq;
                    u32x4 w; w.x = cvt_pk_bf16(v0[0], v0[1]); w.y = cvt_pk_bf16(v0[2], v0[3]); w.z = cvt_pk_bf16(v1[0], v1[1]); w.w = cvt_pk_bf16(v1[2], v1[3]);
                    *(u32x4*)dst = w; } }
    }
};
struct EpiPlain {
    static constexpr bool PERM = true, AFTER_DRAIN = false, HAS_MID = false;
    bf16_t* O; int ldc;
    __device__ __forceinline__ void operator()(const f32x4 (&acc)[2][2][4][2], const Unit& u, int wr, int wc, int fr, int fq) const {
        const int row0 = u.pm * BM + wr * 64 + fr; const int col0 = u.pn * BM + wc * 32 + 8 * fq;
#pragma unroll
        for (int ai = 0; ai < 2; ++ai)
#pragma unroll
            for (int m = 0; m < 4; ++m) { bf16_t* rowp = O + (size_t)(row0 + ai * HALF + m * 16) * ldc + col0;
#pragma unroll
                for (int bj = 0; bj < 2; ++bj) { const f32x4 v0 = acc[ai][bj][m][0], v1 = acc[ai][bj][m][1];
                    u32x4 w; w.x = cvt_pk_bf16(v0[0], v0[1]); w.y = cvt_pk_bf16(v0[2], v0[3]); w.z = cvt_pk_bf16(v1[0], v1[1]); w.w = cvt_pk_bf16(v1[2], v1[3]);
                    *(u32x4*)(rowp + bj * HALF) = w; } }
    }
};
struct EpiProj {
    static constexpr bool PERM = true, AFTER_DRAIN = false, HAS_MID = true;
    const bf16_t* gate; bf16_t* merged;
    static __device__ __forceinline__ bool is_mid(int t) { return t == 16 || t == 24; }
    __device__ __forceinline__ void mid(f32x4 (&acc)[2][2][4][2], const Unit& u, int t, int wr, int wc, int fr, int fq) const {
        const int seg = (t == 16) ? 0 : 1;
        const int row0 = u.pm * BM + wr * 64 + fr; const int col0 = u.pn * BM + wc * 32 + 8 * fq;
        const bf16_t* gbase = gate + (size_t)row0 * 6144 + seg * 2048 + col0;
#pragma unroll
        for (int ai = 0; ai < 2; ++ai)
#pragma unroll
            for (int mh = 0; mh < 2; ++mh) {
                u32x4 a[2][2], b[2][2];
#pragma unroll
                for (int mm = 0; mm < 2; ++mm)
#pragma unroll
                    for (int bj = 0; bj < 2; ++bj) { const bf16_t* gp = gbase + (size_t)(ai * HALF + (mh * 2 + mm) * 16) * 6144 + bj * HALF; a[mm][bj] = *(const u32x4*)gp; b[mm][bj] = *(const u32x4*)(gp + 2048); }
#pragma unroll
                for (int mm = 0; mm < 2; ++mm)
#pragma unroll
                    for (int bj = 0; bj < 2; ++bj) { const int m = mh * 2 + mm; const u32x4 A = a[mm][bj], B = b[mm][bj];
                        f32x4 r0, r1;
                        r0[0] = bf_lo(A.x) * __builtin_amdgcn_rcpf(bf_lo(B.x)); r0[1] = bf_hi(A.x) * __builtin_amdgcn_rcpf(bf_hi(B.x));
                        r0[2] = bf_lo(A.y) * __builtin_amdgcn_rcpf(bf_lo(B.y)); r0[3] = bf_hi(A.y) * __builtin_amdgcn_rcpf(bf_hi(B.y));
                        r1[0] = bf_lo(A.z) * __builtin_amdgcn_rcpf(bf_lo(B.z)); r1[1] = bf_hi(A.z) * __builtin_amdgcn_rcpf(bf_hi(B.z));
                        r1[2] = bf_lo(A.w) * __builtin_amdgcn_rcpf(bf_lo(B.w)); r1[3] = bf_hi(A.w) * __builtin_amdgcn_rcpf(bf_hi(B.w));
                        acc[ai][bj][m][0] = acc[ai][bj][m][0] * r0; acc[ai][bj][m][1] = acc[ai][bj][m][1] * r1; }
                __builtin_amdgcn_sched_barrier(0);
            }
    }
    __device__ __forceinline__ void operator()(const f32x4 (&acc)[2][2][4][2], const Unit& u, int wr, int wc, int fr, int fq) const {
        const int row0 = u.pm * BM + wr * 64 + fr; const int col0 = u.pn * BM + wc * 32 + 8 * fq;
#pragma unroll
        for (int ai = 0; ai < 2; ++ai)
#pragma unroll
            for (int m = 0; m < 4; ++m) { const size_t r = (size_t)(row0 + ai * HALF + m * 16); const bf16_t* gp = gate + r * 6144 + 2 * 2048 + col0; bf16_t* rowp = merged + r * 2048 + col0;
#pragma unroll
                for (int bj = 0; bj < 2; ++bj) { const u32x4 g = *(const u32x4*)(gp + bj * HALF); const f32x4 v0 = acc[ai][bj][m][0], v1 = acc[ai][bj][m][1];
                    u32x4 w; w.x = cvt_pk_bf16(v0[0] * bf_lo(g.x), v0[1] * bf_hi(g.x)); w.y = cvt_pk_bf16(v0[2] * bf_lo(g.y), v0[3] * bf_hi(g.y));
                    w.z = cvt_pk_bf16(v1[0] * bf_lo(g.z), v1[1] * bf_hi(g.z)); w.w = cvt_pk_bf16(v1[2] * bf_lo(g.w), v1[3] * bf_hi(g.w));
                    *(u32x4*)(rowp + bj * HALF) = w; } }
    }
};
struct EpiResid {
    static constexpr bool PERM = true, AFTER_DRAIN = false, HAS_MID = false;
    const float* base32; bf16_t* xb; unsigned long long* ss;
    __device__ __forceinline__ void operator()(const f32x4 (&acc)[2][2][4][2], const Unit& u, int wr, int wc, int fr, int fq) const {
        const int row0 = u.pm * BM + wr * 64 + fr; const int col0 = u.pn * BM + wc * 32 + 8 * fq;
#pragma unroll
        for (int ai = 0; ai < 2; ++ai)
#pragma unroll
            for (int m = 0; m < 4; ++m) { const int row = row0 + ai * HALF + m * 16; const size_t off = (size_t)row * 2048 + col0; float sq = 0.f;
#pragma unroll
                for (int bj = 0; bj < 2; ++bj) { f32x4 b0, b1;
                    if (base32) { b0 = *(const f32x4*)(base32 + off + bj * HALF); b1 = *(const f32x4*)(base32 + off + bj * HALF + 4); }
                    else { const u32x4 p = *(const u32x4*)(xb + off + bj * HALF); b0 = (f32x4){bf_lo(p.x), bf_hi(p.x), bf_lo(p.y), bf_hi(p.y)}; b1 = (f32x4){bf_lo(p.z), bf_hi(p.z), bf_lo(p.w), bf_hi(p.w)}; }
                    const f32x4 v0 = b0 + acc[ai][bj][m][0], v1 = b1 + acc[ai][bj][m][1];
                    u32x4 w; w.x = cvt_pk_bf16(v0[0], v0[1]); w.y = cvt_pk_bf16(v0[2], v0[3]); w.z = cvt_pk_bf16(v1[0], v1[1]); w.w = cvt_pk_bf16(v1[2], v1[3]);
                    *(u32x4*)(xb + off + bj * HALF) = w;
                    const float r0 = bf_lo(w.x), r1 = bf_hi(w.x), r2 = bf_lo(w.y), r3 = bf_hi(w.y), r4 = bf_lo(w.z), r5 = bf_hi(w.z), r6 = bf_lo(w.w), r7 = bf_hi(w.w);
                    sq += ((r0 * r0 + r1 * r1) + (r2 * r2 + r3 * r3)) + ((r4 * r4 + r5 * r5) + (r6 * r6 + r7 * r7)); }
                sq += __shfl_xor(sq, 16); sq += __shfl_xor(sq, 32);
                if (fq == 0) (void)__hip_atomic_fetch_add(ss + row, (unsigned long long)(sq * 1048576.0f + 0.5f), __ATOMIC_RELAXED, __HIP_MEMORY_SCOPE_AGENT); }
    }
};
struct EpiSwiGLU {
    static constexpr bool PERM = true, AFTER_DRAIN = false, HAS_MID = false;
    bf16_t* hid; const unsigned long long* ss;
    __device__ __forceinline__ void operator()(const f32x4 (&acc)[2][2][4][2], const Unit& u, int wr, int wc, int fr, int fq) const {
        const int row0 = u.pm * BM + wr * 64 + fr; const int col0 = u.pn * HALF + wc * 32 + 8 * fq;
#pragma unroll
        for (int ai = 0; ai < 2; ++ai)
#pragma unroll
            for (int m = 0; m < 4; ++m) { bf16_t* rowp = hid + (size_t)(row0 + ai * HALF + m * 16) * 5632 + col0;
                f32x4 h0, h1; const float rs = __builtin_amdgcn_rsqf((float)ss[row0 + ai * HALF + m * 16] * (1.0f / (2048.0f * 1048576.0f)) + 1e-5f);
#pragma unroll
                for (int i = 0; i < 4; ++i) { const float g0 = acc[ai][0][m][0][i] * rs, g1 = acc[ai][0][m][1][i] * rs;
                    h0[i] = g0 * sigmoidf_(g0) * (acc[ai][1][m][0][i] * rs); h1[i] = g1 * sigmoidf_(g1) * (acc[ai][1][m][1][i] * rs); }
                u32x4 w; w.x = cvt_pk_bf16(h0[0], h0[1]); w.y = cvt_pk_bf16(h0[2], h0[3]); w.z = cvt_pk_bf16(h1[0], h1[1]); w.w = cvt_pk_bf16(h1[2], h1[3]);
                *(u32x4*)rowp = w; }
    }
};

template <class Epi, class Sched, bool ALIGN_EPI = false, bool SP2 = false>
__device__ __forceinline__ void gemm_phase(PG8_LAS unsigned char* lds, const Gemm g, const Sched& S, const Epi& E) {
    int tid = threadIdx.x; asm volatile("" : "+v"(tid));
    const int wid = __builtin_amdgcn_readfirstlane(tid >> 6), lane = tid & 63, wr = wid >> 2, wc = wid & 3, fr = lane & 15, fq = lane >> 4;
    const int K = g.K, nt = K / BK;
    unsigned voffA[2], voffB[2];
#pragma unroll
    for (int i = 0; i < 2; ++i) { int R, C; stage_rc(tid * 16 + i * 8192, R, C); const int Rb = Epi::PERM ? ((R & ~31) + perm32(R & 31)) : R;
        voffA[i] = (unsigned)(R * K + C) * 2u; voffB[i] = (unsigned)(Rb * K + C) * 2u; }
    const size_t kstep = (size_t)(BK * 2);
    const size_t hstep = (size_t)HALF * K * 2;
    const size_t tstep = 2 * hstep;
    const unsigned ldsw = (unsigned)wid * 1024u;
    const int aoff = lds_byte(wr * 64 + fr, fq * 8), boff = lds_byte(wc * 32 + fr, fq * 8);
#define PG8_SA(b, h) (((b) * 2 + (h)) * HTB)
#define PG8_SB(b, h) ((4 + (b) * 2 + (h)) * HTB)
#define PG8_STAGE(bufoff, gbase, voff) do { _Pragma("unroll") for (int _i = 0; _i < 2; ++_i) \
        __builtin_amdgcn_global_load_lds((const unsigned*)((const char*)(gbase) + (voff)[_i]), (PG8_LAS unsigned*)(lds + (bufoff) + ldsw + _i * 8192), 16, 0, 0); } while (0)
#define PG8_LDA(dst, b, h) do { _Pragma("unroll") for (int m = 0; m < 4; ++m) _Pragma("unroll") for (int k = 0; k < 2; ++k) dst[m][k] = *(const PG8_LAS bf16x8*)(lds + PG8_SA(b, h) + aoff + m * 2048 + k * 1024); } while (0)
#define PG8_LDB(dst, b, h) do { _Pragma("unroll") for (int n = 0; n < 2; ++n) _Pragma("unroll") for (int k = 0; k < 2; ++k) dst[n][k] = *(const PG8_LAS bf16x8*)(lds + PG8_SB(b, h) + boff + n * 2048 + k * 1024); } while (0)
#define PG8_MMA(ai, bj, At, Bt) do { __builtin_amdgcn_s_setprio(1); _Pragma("unroll") for (int m = 0; m < 4; ++m) _Pragma("unroll") for (int n = 0; n < 2; ++n) _Pragma("unroll") for (int k = 0; k < 2; ++k) \
        acc[ai][bj][m][n] = __builtin_amdgcn_mfma_f32_16x16x32_bf16(Bt[n][k], At[m][k], acc[ai][bj][m][n], 0, 0, 0); __builtin_amdgcn_s_setprio(0); } while (0)
#define PG8_WAIT_V(n) asm volatile("s_waitcnt vmcnt(" #n ")" ::: "memory")
#define PG8_WAIT_L(n) asm volatile("s_waitcnt lgkmcnt(" #n ")" ::: "memory")
#define PG8_BAR __builtin_amdgcn_s_barrier()
#define PG8_SCHED __builtin_amdgcn_sched_barrier(0)
    Unit cur, nxt; int ui = 0;
    if (!S.next(0, cur)) return;
    f32x4 acc[2][2][4][2];
#pragma unroll
    for (int a = 0; a < 2; ++a)
#pragma unroll
        for (int b = 0; b < 2; ++b)
#pragma unroll
            for (int m = 0; m < 4; ++m)
#pragma unroll
                for (int n = 0; n < 2; ++n) acc[a][b][m][n] = (f32x4){0.f, 0.f, 0.f, 0.f};
    bf16x8 At[4][2], B0[2][2], B1[2][2];
    const char* cA = (const char*)g.A + (size_t)cur.pm * tstep; const char* cB = (const char*)g.Bt + (size_t)cur.pn * tstep;
    S.a_ready(cur);
    if constexpr (SP2) {
        PG8_STAGE(PG8_SB(0, 0), cB, voffB); PG8_STAGE(PG8_SB(0, 1), cB + hstep, voffB); PG8_STAGE(PG8_SA(0, 0), cA, voffA); PG8_STAGE(PG8_SA(0, 1), cA + hstep, voffA);
        if (wr == 1) PG8_BAR;
        PG8_WAIT_V(2); PG8_BAR;
        PG8_STAGE(PG8_SB(1, 0), cB + kstep, voffB); PG8_STAGE(PG8_SA(1, 0), cA + kstep, voffA); PG8_STAGE(PG8_SB(1, 1), cB + hstep + kstep, voffB);
        PG8_WAIT_V(6); PG8_BAR;
    } else {
        PG8_STAGE(PG8_SB(0, 0), cB, voffB); PG8_STAGE(PG8_SA(0, 0), cA, voffA); PG8_STAGE(PG8_SB(0, 1), cB + hstep, voffB); PG8_STAGE(PG8_SA(0, 1), cA + hstep, voffA);
        if (wr == 1) PG8_BAR;
        PG8_WAIT_V(4); PG8_BAR;
        PG8_STAGE(PG8_SB(1, 0), cB + kstep, voffB); PG8_STAGE(PG8_SA(1, 0), cA + kstep, voffA); PG8_STAGE(PG8_SB(1, 1), cB + hstep + kstep, voffB);
        PG8_WAIT_V(6); PG8_BAR;
    }
    for (;;) {
        const bool has_next = S.next(ui + 1, nxt);
        const char* nA = has_next ? (const char*)g.A + (size_t)nxt.pm * tstep : cA; const char* nB = has_next ? (const char*)g.Bt + (size_t)nxt.pn * tstep : cB;
        for (int t = 0; t < nt; t += 2) {
            const bool last = (t == nt - 2);
            const char* a1 = cA + (size_t)(t + 1) * kstep;
            const char* a2 = last ? nA : cA + (size_t)(t + 2) * kstep; const char* b2 = last ? nB : cB + (size_t)(t + 2) * kstep;
            const char* a3 = a2 + kstep; const char* b3 = b2 + kstep;
            if (last && has_next) S.a_ready(nxt);
            if constexpr (Epi::HAS_MID) { if (Epi::is_mid(t)) E.mid(acc, cur, t, wr, wc, fr, fq); }
            if constexpr (SP2) {
            PG8_LDB(B0, 0, 0); PG8_LDB(B1, 0, 1); PG8_SCHED; PG8_LDA(At, 0, 0); PG8_STAGE(PG8_SA(1, 1), a1 + hstep, voffA);
            PG8_WAIT_V(8); PG8_WAIT_L(0); PG8_BAR; PG8_MMA(0, 0, At, B0); PG8_MMA(0, 1, At, B1); PG8_BAR; PG8_SCHED;
            PG8_LDA(At, 0, 1); PG8_STAGE(PG8_SB(0, 0), b2, voffB); PG8_STAGE(PG8_SB(0, 1), b2 + hstep, voffB); PG8_STAGE(PG8_SA(0, 0), a2, voffA);
            PG8_WAIT_V(8); PG8_WAIT_L(0); PG8_BAR; PG8_MMA(1, 0, At, B0); PG8_MMA(1, 1, At, B1); PG8_BAR; PG8_SCHED;
            PG8_LDB(B0, 1, 0); PG8_LDB(B1, 1, 1); PG8_SCHED; PG8_LDA(At, 1, 0); PG8_STAGE(PG8_SA(0, 1), a2 + hstep, voffA);
            PG8_WAIT_V(8); PG8_WAIT_L(0); PG8_BAR; PG8_MMA(0, 0, At, B0); PG8_MMA(0, 1, At, B1); PG8_BAR; PG8_SCHED;
            PG8_LDA(At, 1, 1); PG8_STAGE(PG8_SB(1, 0), b3, voffB); PG8_STAGE(PG8_SB(1, 1), b3 + hstep, voffB); PG8_STAGE(PG8_SA(1, 0), a3, voffA);
            PG8_WAIT_V(8); PG8_WAIT_L(0); PG8_BAR; PG8_MMA(1, 0, At, B0); PG8_MMA(1, 1, At, B1); PG8_BAR; PG8_SCHED;
            } else {
            PG8_LDB(B0, 0, 0); PG8_SCHED; PG8_LDA(At, 0, 0); PG8_STAGE(PG8_SA(1, 1), a1 + hstep, voffA);
            PG8_WAIT_L(8); PG8_BAR; PG8_WAIT_L(0); PG8_MMA(0, 0, At, B0); PG8_BAR; PG8_SCHED;
            PG8_LDB(B1, 0, 1); PG8_STAGE(PG8_SB(0, 0), b2, voffB);
            PG8_BAR; PG8_WAIT_L(0); PG8_MMA(0, 1, At, B1); PG8_BAR;
            PG8_LDA(At, 0, 1); PG8_STAGE(PG8_SA(0, 0), a2, voffA);
            PG8_BAR; PG8_WAIT_L(0); PG8_MMA(1, 0, At, B0); PG8_BAR; PG8_SCHED;
            PG8_STAGE(PG8_SB(0, 1), b2 + hstep, voffB);
            PG8_WAIT_V(6); PG8_BAR; PG8_MMA(1, 1, At, B1); PG8_BAR;
            PG8_LDB(B0, 1, 0); PG8_SCHED; PG8_LDA(At, 1, 0); PG8_STAGE(PG8_SA(0, 1), a2 + hstep, voffA);
            PG8_WAIT_L(8); PG8_BAR; PG8_WAIT_L(0); PG8_MMA(0, 0, At, B0); PG8_BAR; PG8_SCHED;
            PG8_LDB(B1, 1, 1); PG8_STAGE(PG8_SB(1, 0), b3, voffB);
            PG8_BAR; PG8_WAIT_L(0); PG8_MMA(0, 1, At, B1); PG8_BAR;
            PG8_LDA(At, 1, 1); PG8_STAGE(PG8_SA(1, 0), a3, voffA);
            PG8_BAR; PG8_WAIT_L(0); PG8_MMA(1, 0, At, B0); PG8_BAR; PG8_SCHED;
            PG8_STAGE(PG8_SB(1, 1), b3 + hstep, voffB);
            PG8_WAIT_V(6); PG8_BAR; PG8_MMA(1, 1, At, B1); PG8_BAR;
            }
        }
        if constexpr (ALIGN_EPI) { if (wr == 0) PG8_BAR; }
        if constexpr (!Epi::AFTER_DRAIN) { E(acc, cur, wr, wc, fr, fq); S.done(cur); }
        if (!has_next) break;
#pragma unroll
        for (int a = 0; a < 2; ++a)
#pragma unroll
            for (int b = 0; b < 2; ++b)
#pragma unroll
                for (int m = 0; m < 4; ++m)
#pragma unroll
                    for (int n = 0; n < 2; ++n) acc[a][b][m][n] = (f32x4){0.f, 0.f, 0.f, 0.f};
        cur = nxt; cA = nA; cB = nB; ++ui;
        if constexpr (ALIGN_EPI) { if (wr == 1) PG8_BAR; }
    }
    PG8_WAIT_V(0);
    if constexpr (!ALIGN_EPI) { if (wr == 0) PG8_BAR; }
    PG8_BAR;
#undef PG8_SA
#undef PG8_SB
#undef PG8_STAGE
#undef PG8_LDA
#undef PG8_LDB
#undef PG8_MMA
#undef PG8_WAIT_V
#undef PG8_WAIT_L
#undef PG8_BAR
#undef PG8_SCHED
}
}

constexpr int DM = 2048, NB = 4, SEQ = 2048, DEPTH = 4, MTOK = NB * SEQ;
constexpr int MEML = 256, NIN = 8192, NGATE = 6144, DFF = 5632;
constexpr float EPS = 1e-5f;
constexpr float LOG2E = 1.4426950408889634f;
#define QKV_AT(b_, s_, col_) ((size_t)(((((col_) >> 7) * NB + (b_)) * SEQ + (s_))) * 128 + ((col_) & 127))
constexpr int C_QA = 0, C_KA = 1024, C_VA = 2048, C_QB = 3072, C_KB = 4608, C_VB = 6144, C_QC = 7680;

typedef unsigned short bf16;
typedef unsigned v4u __attribute__((ext_vector_type(4)));
typedef unsigned v2u __attribute__((ext_vector_type(2)));
typedef float f32x4 __attribute__((ext_vector_type(4)));
#define LAS __attribute__((address_space(3)))

namespace att {
__device__ __forceinline__ int ltid() { int t = threadIdx.x; asm volatile("" : "+v"(t)); return t; }
using bf16x8 = __attribute__((ext_vector_type(8))) short;
using s16x4  = __attribute__((ext_vector_type(4))) short;
using f32x16 = __attribute__((ext_vector_type(16))) float;
using u32x4  = __attribute__((ext_vector_type(4))) unsigned;
constexpr int NW = 8, QBLK = 32, KVBLK = 64;
constexpr int SHM_V = 16384, SHM_K = 16384;
constexpr int OFF_V = 0, OFF_K = 32768, OFF_WS = 65536, OFF_TAB = 65536 + 2048;
constexpr float THR2 = 11.5f;
#define KSWZ(row, colB) ((row) * 256 + ((colB) ^ (((row) & 7) << 4)))
#define SBAR() __builtin_amdgcn_sched_barrier(0)
__device__ __forceinline__ int crow(int r, int hi) { return (r & 3) + 8 * (r >> 2) + 4 * hi; }
__device__ __forceinline__ unsigned cvtpk(float lo, float hi) { unsigned r; asm volatile("v_cvt_pk_bf16_f32 %0, %1, %2" : "=v"(r) : "v"(lo), "v"(hi)); return r; }
__device__ __forceinline__ bf16x8 ld8(const bf16* p) { return *reinterpret_cast<const bf16x8*>(p); }

__device__ __forceinline__ void partialSM(f32x16& p0, f32x16& p1, float& m_reg, float& mn, float& alpha) {
  float pmax = p0[0];
#pragma unroll
  for (int r = 1; r < 16; ++r) pmax = fmaxf(pmax, p0[r]);
#pragma unroll
  for (int r = 0; r < 16; ++r) pmax = fmaxf(pmax, p1[r]);
  { auto rr = __builtin_amdgcn_permlane32_swap(__float_as_uint(pmax), __float_as_uint(pmax), false, false);
    pmax = fmaxf(__uint_as_float(rr[0]), __uint_as_float(rr[1])); }
  if (__builtin_expect(__all(pmax - m_reg <= THR2), 1)) { mn = m_reg; alpha = 1.f; }
  else { mn = fmaxf(m_reg, pmax); alpha = __builtin_amdgcn_exp2f(m_reg - mn); m_reg = mn; }
#pragma unroll
  for (int r = 0; r < 16; ++r) p0[r] = p0[r] - mn;
#pragma unroll
  for (int r = 0; r < 16; ++r) p1[r] = p1[r] - mn;
#pragma unroll
  for (int r = 0; r < 16; ++r) p0[r] = __builtin_amdgcn_exp2f(p0[r]);
}
__device__ __forceinline__ void finishSM(f32x16& p0, f32x16& p1, float alpha, float& l_reg, bf16x8& pa0, bf16x8& pa1, bf16x8& pa2, bf16x8& pa3) {
#pragma unroll
  for (int r = 0; r < 16; ++r) p1[r] = __builtin_amdgcn_exp2f(p1[r]);
  float ps = 0;
#pragma unroll
  for (int r = 0; r < 16; ++r) ps += p0[r];
#pragma unroll
  for (int r = 0; r < 16; ++r) ps += p1[r];
  { auto rr = __builtin_amdgcn_permlane32_swap(__float_as_uint(ps), __float_as_uint(ps), false, false);
    ps = __uint_as_float(rr[0]) + __uint_as_float(rr[1]); }
  l_reg = l_reg * alpha + ps;
#define PK4(P, BASE, OUT) do { unsigned a0 = cvtpk(P[BASE + 0], P[BASE + 1]), a1 = cvtpk(P[BASE + 2], P[BASE + 3]);   \
    unsigned b0 = cvtpk(P[BASE + 4], P[BASE + 5]), b1 = cvtpk(P[BASE + 6], P[BASE + 7]);                              \
    auto r0 = __builtin_amdgcn_permlane32_swap(a0, b0, false, false); auto r1 = __builtin_amdgcn_permlane32_swap(a1, b1, false, false); \
    u32x4 w = {r0[0], r1[0], r0[1], r1[1]}; OUT = *reinterpret_cast<bf16x8*>(&w); } while (0)
  PK4(p0, 0, pa0); PK4(p0, 8, pa1); PK4(p1, 0, pa2); PK4(p1, 8, pa3);
#undef PK4
}
template <int ND> __device__ __forceinline__ void qkt(f32x16& p0, f32x16& p1, const bf16* Ks, const bf16x8* qr, int doff, int r32, int hi) {
  p0 = f32x16{}; p1 = f32x16{};
#pragma unroll
  for (int d0 = 0; d0 < ND; ++d0) { const int cb = ((doff + d0) * 16 + hi * 8) * 2;
    bf16x8 b0 = *reinterpret_cast<const bf16x8*>((const char*)Ks + KSWZ(r32, cb));
    bf16x8 b1 = *reinterpret_cast<const bf16x8*>((const char*)Ks + KSWZ(32 + r32, cb));
    p0 = __builtin_amdgcn_mfma_f32_32x32x16_bf16(b0, qr[d0], p0, 0, 0, 0);
    p1 = __builtin_amdgcn_mfma_f32_32x32x16_bf16(b1, qr[d0], p1, 0, 0, 0); }
}
__device__ __forceinline__ int v_st(int k, int c) { const int kk = (k & ~0xC) | ((k & 4) << 1) | ((k & 8) >> 1); return ((kk >> 3) * 4 + (c >> 5)) * 512 + ((kk & 7) * 32 + (c & 31)) * 2; }
__device__ __forceinline__ int v_rd_base(int lane) { return ((lane & 3) << 3) | (((lane >> 2) & 3) << 6) | (((lane >> 4) & 1) << 5) | (((lane >> 5) & 1) << 8); }
constexpr int v_rd_off(int d0, int ks, int half) { return d0 * 512 + ks * 4096 + half * 2048; }
template <int OFF> __device__ __forceinline__ s16x4 tr_read(int vb) {
  s16x4 r; asm volatile("ds_read_b64_tr_b16 %0, %1 offset:%2" : "=&v"(r) : "v"(vb), "i"(OFF) : "memory"); return r;
}
template <int D0> __device__ __forceinline__ void pv_one(f32x16& od, int vb, bf16x8 pa0, bf16x8 pa1, bf16x8 pa2, bf16x8 pa3) {
  const s16x4 l0 = tr_read<v_rd_off(D0, 0, 0)>(vb), h0 = tr_read<v_rd_off(D0, 0, 1)>(vb), l1 = tr_read<v_rd_off(D0, 1, 0)>(vb), h1 = tr_read<v_rd_off(D0, 1, 1)>(vb);
  const s16x4 l2 = tr_read<v_rd_off(D0, 2, 0)>(vb), h2 = tr_read<v_rd_off(D0, 2, 1)>(vb), l3 = tr_read<v_rd_off(D0, 3, 0)>(vb), h3 = tr_read<v_rd_off(D0, 3, 1)>(vb);
  asm volatile("s_waitcnt lgkmcnt(0)" ::: "memory"); SBAR();
#define PK(L, H) (bf16x8){L[0], L[1], L[2], L[3], H[0], H[1], H[2], H[3]}
  od = __builtin_amdgcn_mfma_f32_32x32x16_bf16(pa0, PK(l0, h0), od, 0, 0, 0);
  od = __builtin_amdgcn_mfma_f32_32x32x16_bf16(pa1, PK(l1, h1), od, 0, 0, 0);
  od = __builtin_amdgcn_mfma_f32_32x32x16_bf16(pa2, PK(l2, h2), od, 0, 0, 0);
  od = __builtin_amdgcn_mfma_f32_32x32x16_bf16(pa3, PK(l3, h3), od, 0, 0, 0);
#undef PK
}
__device__ __forceinline__ void pv_d0(f32x16* o, int vb, bf16x8 pa0, bf16x8 pa1, bf16x8 pa2, bf16x8 pa3) {
  pv_one<0>(o[0], vb, pa0, pa1, pa2, pa3); pv_one<1>(o[1], vb, pa0, pa1, pa2, pa3); pv_one<2>(o[2], vb, pa0, pa1, pa2, pa3); pv_one<3>(o[3], vb, pa0, pa1, pa2, pa3);
}

__device__ __forceinline__ int rel_bucket(int rel) {
  const int n = rel < 0 ? -rel : rel;
  const int v = n < 8 ? n : (n < 15 ? 8 : (n < 27 ? 9 : (n < 50 ? 10 : (n < 91 ? 11 : (n < 166 ? 12 : (n < 305 ? 13 : (n < 559 ? 14 : 15)))))));
  return (rel > 0 ? 16 : 0) + v;
}

template <class P> __device__ __forceinline__ void attn_unit(P& pol, char* lds) {
  const int tid = ltid(), wid = tid >> 6, lane = tid & 63, r32 = lane & 31, hi = lane >> 5;
  bf16* V_lds = (bf16*)(lds + OFF_V); bf16* K_lds = (bf16*)(lds + OFF_K);
  float* ws = (float*)(lds + OFF_WS) + wid * 64; float* li_l = ws; float* al_l = ws + 32;
  float m_reg = -1e30f, l_reg = 0; f32x16 o[4] = {}; bf16x8 qr[P::ND];
  const bf16* Qw = pol.qptr() + hi * 8;
#pragma unroll
  for (int d0 = 0; d0 < P::ND; ++d0) qr[d0] = ld8(Qw + d0 * 16);
  const int sr = tid >> 4, sc = (tid & 15) * 8, vst0 = v_st(sr, sc), vst1 = v_st(32 + sr, sc);
  const int vb0 = (int)(uintptr_t)V_lds + v_rd_base(lane);
  const int doff = pol.doff();
  struct { bf16x8 vs0, vs1, ks0, ks1; } sr_[1];
#define SLOAD(i, t) do { sr_[i].vs0 = ld8(pol.vrow((t), sr) + sc); sr_[i].vs1 = ld8(pol.vrow((t), 32 + sr) + sc); \
    sr_[i].ks0 = ld8(pol.krow((t), sr) + sc); sr_[i].ks1 = ld8(pol.krow((t), 32 + sr) + sc); } while (0)
#define SWRITE(b, i) do { *(bf16x8*)((char*)V_lds + (b) * SHM_V + vst0) = sr_[i].vs0;          \
    *(bf16x8*)((char*)V_lds + (b) * SHM_V + vst1) = sr_[i].vs1; int kc = sc * 2;               \
    *(bf16x8*)((char*)K_lds + (b) * SHM_K + KSWZ(sr, kc)) = sr_[i].ks0;                       \
    *(bf16x8*)((char*)K_lds + (b) * SHM_K + KSWZ(32 + sr, kc)) = sr_[i].ks1; } while (0)
#define RESC(a) do { if (__any((a) < 1.f)) { if (hi == 0) al_l[r32] = (a); asm volatile("s_waitcnt lgkmcnt(0)" ::: "memory"); \
    _Pragma("unroll") for (int d = 0; d < 4; ++d) _Pragma("unroll") for (int r = 0; r < 16; ++r) o[d][r] *= al_l[crow(r, hi)]; } } while (0)
  s16x4 vA[8], vB[8];
#define VRD8(dst, vb, D0) do { dst[0] = tr_read<v_rd_off(D0, 0, 0)>(vb); dst[1] = tr_read<v_rd_off(D0, 0, 1)>(vb); dst[2] = tr_read<v_rd_off(D0, 1, 0)>(vb); dst[3] = tr_read<v_rd_off(D0, 1, 1)>(vb); \
    dst[4] = tr_read<v_rd_off(D0, 2, 0)>(vb); dst[5] = tr_read<v_rd_off(D0, 2, 1)>(vb); dst[6] = tr_read<v_rd_off(D0, 3, 0)>(vb); dst[7] = tr_read<v_rd_off(D0, 3, 1)>(vb); } while (0)
#define PKV(L, H) (bf16x8){L[0], L[1], L[2], L[3], H[0], H[1], H[2], H[3]}
#define PVM(od, src) do { od = __builtin_amdgcn_mfma_f32_32x32x16_bf16(pa0, PKV(src[0], src[1]), od, 0, 0, 0); od = __builtin_amdgcn_mfma_f32_32x32x16_bf16(pa1, PKV(src[2], src[3]), od, 0, 0, 0); \
    od = __builtin_amdgcn_mfma_f32_32x32x16_bf16(pa2, PKV(src[4], src[5]), od, 0, 0, 0); od = __builtin_amdgcn_mfma_f32_32x32x16_bf16(pa3, PKV(src[6], src[7]), od, 0, 0, 0); } while (0)
#define LW(n) asm volatile("s_waitcnt lgkmcnt(" #n ")" ::: "memory")
#define PVREST(vb) do { SBAR(); VRD8(vB, (vb), 1); LW(8); SBAR(); PVM(o[0], vA); SBAR(); VRD8(vA, (vb), 2); LW(8); SBAR(); PVM(o[1], vB); SBAR(); \
    VRD8(vB, (vb), 3); LW(8); SBAR(); PVM(o[2], vA); SBAR(); LW(0); SBAR(); PVM(o[3], vB); SBAR(); } while (0)
  f32x16 pA0, pA1, pB0, pB1; float mnA, mnB, alA, alB; bf16x8 pa0, pa1, pa2, pa3; constexpr int NT = P::NT;
  SLOAD(0, 0);
  pol.prep(lds);
  asm volatile("s_waitcnt vmcnt(0)" ::: "memory"); SWRITE(0, 0); __syncthreads();
  SLOAD(0, 1);
  qkt<P::ND>(pA0, pA1, K_lds, qr, doff, r32, hi); pol.transform(pA0, pA1, 0); partialSM(pA0, pA1, m_reg, mnA, alA);
  SWRITE(1, 0); __syncthreads();
  for (int j = 1; j + 1 < NT; j += 2) {
    SBAR(); SLOAD(0, j + 1); SBAR();
    qkt<P::ND>(pB0, pB1, (bf16*)((char*)K_lds + SHM_K), qr, doff, r32, hi);
    SBAR(); VRD8(vA, vb0, 0); SBAR();
    finishSM(pA0, pA1, alA, l_reg, pa0, pa1, pa2, pa3);
    PVREST(vb0);
    pol.transform(pB0, pB1, j); partialSM(pB0, pB1, m_reg, mnB, alB);
    __syncthreads(); SWRITE(0, 0);
    RESC(alB); __syncthreads();
    SBAR(); SLOAD(0, j + 2); SBAR();
    qkt<P::ND>(pA0, pA1, K_lds, qr, doff, r32, hi);
    SBAR(); VRD8(vA, vb0 + (int)SHM_V, 0); SBAR();
    finishSM(pB0, pB1, alB, l_reg, pa0, pa1, pa2, pa3);
    PVREST(vb0 + (int)SHM_V);
    pol.transform(pA0, pA1, j + 1); partialSM(pA0, pA1, m_reg, mnA, alA);
    __syncthreads(); SWRITE(1, 0);
    RESC(alA); __syncthreads();
  }
  SBAR(); qkt<P::ND>(pB0, pB1, (bf16*)((char*)K_lds + SHM_K), qr, doff, r32, hi);
  SBAR(); VRD8(vA, vb0, 0); SBAR();
  finishSM(pA0, pA1, alA, l_reg, pa0, pa1, pa2, pa3);
  PVREST(vb0);
  pol.transform(pB0, pB1, NT - 1); partialSM(pB0, pB1, m_reg, mnB, alB);
  RESC(alB);
  SBAR(); VRD8(vA, vb0 + (int)SHM_V, 0); SBAR();
  finishSM(pB0, pB1, alB, l_reg, pa0, pa1, pa2, pa3);
  PVREST(vb0 + (int)SHM_V);
#undef VRD8
#undef PKV
#undef PVM
#undef LW
#undef PVREST
  pol.epilogue(o, m_reg, l_reg, li_l, lds);
#undef SLOAD
#undef SWRITE
#undef RESC
}


#define ATT_STORE_TILE(stg_, VAL, ROWPTR) do { unsigned short* stg__ = (unsigned short*)(stg_); \
    _Pragma("unroll") for (int r = 0; r < 16; ++r) { const int row__ = crow(r, hi); \
      _Pragma("unroll") for (int d = 0; d < 4; ++d) { const float v__ = (VAL); stg__[row__ * 128 + d * 32 + r32] = (unsigned short)(cvtpk(v__, v__) & 0xffffu); } \
      if ((r & 3) == 3) __builtin_amdgcn_sched_barrier(0); } \
    asm volatile("s_waitcnt lgkmcnt(0)" ::: "memory"); \
    const int ln__ = (ltid() & 63); \
    _Pragma("unroll") for (int i = 0; i < 8; ++i) { const int row = 4 * i + (ln__ >> 4); const u32x4 w__ = *(const u32x4*)(stg__ + row * 128 + (ln__ & 15) * 8); \
      *(u32x4*)((ROWPTR) + (ln__ & 15) * 8) = w__; if (i & 1) __builtin_amdgcn_sched_barrier(0); } } while (0)

struct PolA {
  static constexpr int ND = 4, NT = SEQ / KVBLK;
  const bf16* qkv; bf16* obuf; const float* subg; float lam, post;
  int b, h, q0, qg, m, r32, hi; const float* tp0;
  const float* relb_;
  __device__ __forceinline__ void init(const bf16* qkv_, bf16* obuf_, const float* subg_, float lam_, float post_, int b_, int h_, int q0_, const float* relb, char* lds) {
    qkv = qkv_; obuf = obuf_; subg = subg_; lam = lam_; post = post_; b = b_; h = h_; q0 = q0_; relb_ = relb;
    const int tid = ltid(), wid = tid >> 6, lane = tid & 63; qg = wid >> 1; m = wid & 1; r32 = lane & 31; hi = lane >> 5;
    float* tab = (float*)(lds + OFF_TAB);
    const int sq = q0 + 32 * qg + r32;
    tp0 = tab + m * 4096 + (4 * hi - sq + 2047);
  }
  __device__ __forceinline__ void prep(char* lds) const {
    const int tid = ltid(); float* tab = (float*)(lds + OFF_TAB); float* colv = tab + 8192;
    if (tid < 64) colv[tid] = relb_[(tid & 31) * 28 + (tid >> 5) * 8 + h] * LOG2E;
    __syncthreads();
#pragma unroll 4
    for (int i = tid; i < 2 * 4096; i += 512) { const int mm = i >> 12, rel = (i & 4095) - 2047; tab[i] = colv[mm * 32 + rel_bucket(rel)]; }
  }
  __device__ __forceinline__ const bf16* qptr() const { return qkv + QKV_AT(b, q0 + 32 * qg + r32, C_QA + h * 128 + m * 64); }
  __device__ __forceinline__ const bf16* krow(int t, int row) const { return qkv + QKV_AT(b, 64 * t + row, C_KA + h * 128); }
  __device__ __forceinline__ const bf16* vrow(int t, int row) const { return qkv + QKV_AT(b, 64 * t + row, C_VA + h * 128); }
  __device__ __forceinline__ int doff() const { return 4 * m; }
  __device__ __forceinline__ void transform(f32x16& p0, f32x16& p1, int t) const {
    constexpr float C = 0.125f * LOG2E; const float* tp = tp0 + 64 * t;
#pragma unroll
    for (int r = 0; r < 16; ++r) { p0[r] = fmaf(p0[r], C, tp[(r & 3) + 8 * (r >> 2)]); p1[r] = fmaf(p1[r], C, tp[32 + (r & 3) + 8 * (r >> 2)]); }
  }
  __device__ __forceinline__ void epilogue(f32x16* o, float m_reg, float l_reg, float* li_l, char* lds) const {
    if (hi == 0) li_l[r32] = l_reg; asm volatile("s_waitcnt lgkmcnt(0)" ::: "memory");
    const float sc = m ? lam : 1.0f;
#pragma unroll
    for (int r = 0; r < 16; ++r) { const float rl = __builtin_amdgcn_rcpf(li_l[crow(r, hi)]) * sc;
#pragma unroll
      for (int d = 0; d < 4; ++d) o[d][r] *= rl; }
    __syncthreads();
    float* X = (float*)lds; const int lane = ltid() & 63;
    if (m == 1) {
#pragma unroll
      for (int d = 0; d < 4; ++d)
#pragma unroll
        for (int r = 0; r < 16; ++r) X[((qg * 4 + d) * 16 + r) * 64 + lane] = o[d][r];
    }
    __syncthreads();
    if (m == 0) {
      float ss[16];
#pragma unroll
      for (int r = 0; r < 16; ++r) { float s = 0.f;
#pragma unroll
        for (int d = 0; d < 4; ++d) { o[d][r] -= X[((qg * 4 + d) * 16 + r) * 64 + lane]; s += o[d][r] * o[d][r]; }
        ss[r] = s; }
#pragma unroll
      for (int off = 1; off < 32; off <<= 1)
#pragma unroll
        for (int r = 0; r < 16; ++r) ss[r] += __shfl_xor(ss[r], off);
      float gsub[4]; unsigned pbits = __float_as_uint(post); asm volatile("" : "+s"(pbits));
      const float oscale = 1.0f - __uint_as_float(pbits);
#pragma unroll
      for (int d = 0; d < 4; ++d) gsub[d] = subg[d * 32 + r32] * oscale;
      float rn[16];
#pragma unroll
      for (int r = 0; r < 16; ++r) rn[r] = __builtin_amdgcn_rsqf(ss[r] * (1.0f / 128.0f) + EPS);
      ATT_STORE_TILE(lds + OFF_TAB + qg * 8192, o[d][r] * rn[r] * gsub[d], obuf + (size_t)(b * SEQ + q0 + 32 * qg + row) * DM + h * 128);
    }
    __syncthreads();
  }
};

struct PolB {
  static constexpr int ND = 8, NT = 6;
  const bf16* qkv; bf16* ob; float* lse;
  int b, g, hb, P0, l2L, dsh, pq, lo, hi_, r32, hi, wid; const float* tp0;
  __device__ __forceinline__ int tok(int p) const { return ((p & ((1 << l2L) - 1)) << dsh) + (p >> l2L); }
  const float* relb_;
  __device__ __forceinline__ void init(const bf16* qkv_, bf16* ob_, float* lse_, int b_, int g_, int hb_, int P0_, const float* relb, char* lds) {
    qkv = qkv_; ob = ob_; lse = lse_; b = b_; g = g_; hb = hb_; P0 = P0_; dsh = 2 * g; l2L = 11 - dsh; relb_ = relb;
    const int tid = ltid(), lane = tid & 63; wid = tid >> 6; r32 = lane & 31; hi = lane >> 5;
    float* tab = (float*)(lds + OFF_TAB);
    pq = P0 + 32 * wid + r32;
    const int cs = (pq >> l2L) << l2L, ce = cs + (1 << l2L) - 1;
    lo = pq - 64 > cs ? pq - 64 : cs; hi_ = pq + 64 < ce ? pq + 64 : ce;
    tp0 = tab + (P0 - 64 + 4 * hi - pq + 320);
  }
  __device__ __forceinline__ void prep(char* lds) const {
    const int tid = ltid(); float* tab = (float*)(lds + OFF_TAB); float* colv = tab + 8192;
    if (tid < 32) colv[tid] = relb_[tid * 28 + 16 + 4 * g + hb] * LOG2E;
    __syncthreads();
    for (int i = tid; i < 640; i += 512) { const int dp = i - 320; tab[i] = (dp >= -64 && dp <= 64) ? colv[rel_bucket(dp * (1 << dsh))] : 0.f; }
  }
  __device__ __forceinline__ const bf16* qptr() const { return qkv + QKV_AT(b, tok(pq), C_QB + g * 512 + hb * 128); }
  __device__ __forceinline__ const bf16* krow(int t, int row) const { int p = P0 - 64 + 64 * t + row; p = p < 0 ? 0 : (p > SEQ - 1 ? SEQ - 1 : p);
    return qkv + QKV_AT(b, tok(p), C_KB + g * 512 + hb * 128); }
  __device__ __forceinline__ const bf16* vrow(int t, int row) const { int p = P0 - 64 + 64 * t + row; p = p < 0 ? 0 : (p > SEQ - 1 ? SEQ - 1 : p);
    return qkv + QKV_AT(b, tok(p), C_VB + g * 512 + hb * 128); }
  __device__ __forceinline__ int doff() const { return 0; }
  __device__ __forceinline__ void transform(f32x16& p0, f32x16& p1, int t) const {
    constexpr float C = 0.08838834764831845f * LOG2E; const float* tp = tp0 + 64 * t; const int kp0 = P0 - 64 + 64 * t + 4 * hi;
#pragma unroll
    for (int r = 0; r < 16; ++r) { const int c = (r & 3) + 8 * (r >> 2); const int kpa = kp0 + c, kpb = kp0 + 32 + c;
      const float va = fmaf(p0[r], C, tp[c]), vb = fmaf(p1[r], C, tp[32 + c]);
      p0[r] = (kpa >= lo && kpa <= hi_) ? va : -1e30f; p1[r] = (kpb >= lo && kpb <= hi_) ? vb : -1e30f; }
  }
  __device__ __forceinline__ void epilogue(f32x16* o, float m_reg, float l_reg, float* li_l, char* lds) const {
    if (hi == 0) { li_l[r32] = l_reg; lse[(size_t)(b * SEQ + tok(pq)) * 4 + hb] = m_reg + __builtin_amdgcn_logf(l_reg); }
    asm volatile("s_waitcnt lgkmcnt(0)" ::: "memory");
    float rl[16];
#pragma unroll
    for (int r = 0; r < 16; ++r) rl[r] = __builtin_amdgcn_rcpf(li_l[crow(r, hi)]);
    __syncthreads();
    ATT_STORE_TILE(lds + wid * 8192, o[d][r] * rl[r], ob + (size_t)(b * SEQ + tok(P0 + 32 * wid + row)) * 512 + hb * 128);
    __syncthreads();
  }
};

struct PolC {
  static constexpr int ND = 8, NT = MEML / KVBLK;
  const bf16* qkv; const bf16* memkv; bf16* obuf; int b, h, q0, r32, hi, wid;
  __device__ __forceinline__ void init(const bf16* qkv_, const bf16* memkv_, bf16* obuf_, int b_, int h_, int q0_) {
    qkv = qkv_; memkv = memkv_; obuf = obuf_; b = b_; h = h_; q0 = q0_; const int tid = ltid(), lane = tid & 63; wid = tid >> 6; r32 = lane & 31; hi = lane >> 5; }
  __device__ __forceinline__ void prep(char*) const {}
  __device__ __forceinline__ const bf16* qptr() const { return qkv + QKV_AT(b, q0 + 32 * wid + r32, C_QC + h * 128); }
  __device__ __forceinline__ const bf16* krow(int t, int row) const { return memkv + (size_t)(b * MEML + 64 * t + row) * 4096 + h * 128; }
  __device__ __forceinline__ const bf16* vrow(int t, int row) const { return memkv + (size_t)(b * MEML + 64 * t + row) * 4096 + 512 + h * 128; }
  __device__ __forceinline__ int doff() const { return 0; }
  __device__ __forceinline__ void transform(f32x16& p0, f32x16& p1, int) const {
    constexpr float C = 0.08838834764831845f * LOG2E;
#pragma unroll
    for (int r = 0; r < 16; ++r) { p0[r] *= C; p1[r] *= C; }
  }
  __device__ __forceinline__ void epilogue(f32x16* o, float m_reg, float l_reg, float* li_l, char* lds) const {
    if (hi == 0) li_l[r32] = l_reg; asm volatile("s_waitcnt lgkmcnt(0)" ::: "memory");
    float rl[16];
#pragma unroll
    for (int r = 0; r < 16; ++r) rl[r] = __builtin_amdgcn_rcpf(li_l[crow(r, hi)]);
    __syncthreads();
    ATT_STORE_TILE(lds + wid * 8192, o[d][r] * rl[r], obuf + (size_t)(b * SEQ + q0 + 32 * wid + row) * DM + 1536 + h * 128);
    __syncthreads();
  }
};
#undef SBAR
}

constexpr size_t MiB = 1u << 20;
constexpr size_t WS_CTL = 0, CTL_ZERO_BYTES = 2 * MiB;
constexpr size_t WS_X    = 2 * MiB;
constexpr size_t WS_H    = WS_X + 64 * MiB;
constexpr size_t WS_QKV  = WS_H + 32 * MiB;
constexpr size_t WS_HID  = WS_QKV;
constexpr size_t WS_GATE = WS_QKV + 128 * MiB;
constexpr size_t WS_OBUF = WS_GATE + 96 * MiB;
constexpr size_t WS_MRG  = WS_OBUF + 32 * MiB;
constexpr size_t WS_OB3  = WS_MRG + 32 * MiB;
constexpr size_t WS_LSE  = WS_OB3 + 48 * MiB;
constexpr size_t WS_MEMN = WS_LSE + 1 * MiB;
constexpr size_t WS_MEMKV= WS_MEMN + 4 * MiB;
constexpr size_t WS_WMEM = WS_MEMKV + 8 * MiB;
constexpr size_t WS_WIN  = WS_WMEM + 16 * MiB;
constexpr size_t WS_WPRJ = WS_WIN + 56 * MiB;
constexpr size_t WS_WOUT = WS_WPRJ + 8 * MiB;
constexpr size_t WS_WFF  = WS_WOUT + 8 * MiB;
constexpr size_t WS_WDN  = WS_WFF + 44 * MiB;
constexpr size_t WS_END  = WS_WDN + 22 * MiB;
constexpr int CW_BAR = 4096;

constexpr int RING_BYTES = 131072, LDSCTL_OFF = RING_BYTES, MISC_OFF = LDSCTL_OFF + 320, LDS_BYTES = 147456;
constexpr int NWAVES = 8;

#define LDS_WAIT() asm volatile("s_waitcnt lgkmcnt(0)" ::: "memory")
#define VM_WAIT() asm volatile("s_waitcnt vmcnt(0)" ::: "memory")

#define XB_TMO      128
#define XB_XCNT(j)  (256  + 64 * (j))
#define XB_XSUB(j)  (1280 + 64 * (j))
#define XB_XGEN(j)  (2304 + 64 * (j))
#define XB_TOP      3328
#define XB_TOPGEN   3392
#define XCD_BAR_WORDS 3456
#define XB_SPIN_CAP (1u << 18)
__device__ __forceinline__ unsigned xb_ld(unsigned* p)              { return __hip_atomic_load(p, __ATOMIC_RELAXED, __HIP_MEMORY_SCOPE_AGENT); }
__device__ __forceinline__ unsigned xb_add(unsigned* p, unsigned v) { return __hip_atomic_fetch_add(p, v, __ATOMIC_RELAXED, __HIP_MEMORY_SCOPE_AGENT); }
__device__ __forceinline__ unsigned xb_xcc_id() { return (unsigned)__builtin_amdgcn_s_getreg((3 << 11) | 20) & 0xFu; }
#define XB_SPIN(cond, bar) do { unsigned _sp = 0; while (cond) { __builtin_amdgcn_s_sleep(1); \
    if ((++_sp & 255u) == 0u) { if (xb_ld(&(bar)[XB_TMO])) break; if (_sp > XB_SPIN_CAP) { atomicAdd(&(bar)[XB_TMO], 1u); break; } } } } while (0)
struct XcdBarrier { unsigned* bar; unsigned x; volatile LAS unsigned* st; };
__device__ __forceinline__ XcdBarrier xcd_barrier_post(unsigned* bar, volatile LAS unsigned* st) {
    XcdBarrier b; b.bar = bar; b.x = xb_xcc_id(); b.st = st;
    if (threadIdx.x == 0) (void)xb_add(&bar[XB_XCNT(b.x)], 1u);
    return b;
}
__device__ __forceinline__ void xcd_barrier_complete(unsigned* bar, unsigned x, unsigned& nloc, unsigned& nx) {
    const unsigned G = gridDim.x * gridDim.y * gridDim.z;
    unsigned sum, cnt, mine, sp = 0u;
    for (;;) {
        sum = 0u; cnt = 0u; mine = 0u;
#pragma unroll
        for (unsigned j = 0; j < 16; ++j) { const unsigned c = xb_ld(&bar[XB_XCNT(j)]); sum += c; cnt += (c > 0u) ? 1u : 0u; mine = (j == x) ? c : mine; }
        if (sum == G) break;
        __builtin_amdgcn_s_sleep(1);
        if ((++sp & 255u) == 0u) { if (xb_ld(&bar[XB_TMO])) break; if (sp > XB_SPIN_CAP) { atomicAdd(&bar[XB_TMO], 1u); break; } }
    }
    nloc = mine > 0u ? mine : 1u; nx = cnt > 0u ? cnt : 1u;
}
__device__ __forceinline__ void xcd_barrier(const XcdBarrier& b) {
    asm volatile("s_waitcnt vmcnt(0)" ::: "memory");
    __syncthreads();
    if (threadIdx.x == 0) {
        unsigned* bar = b.bar;
        __builtin_amdgcn_s_waitcnt(0);
        unsigned nloc = b.st[0], nx = b.st[1];
        if (nloc == 0u) { xcd_barrier_complete(bar, b.x, nloc, nx); b.st[0] = nloc; b.st[1] = nx; }
        const unsigned old = xb_add(&bar[XB_XSUB(b.x)], 1u);
        const unsigned gen = old / nloc;
        if (old + 1u == (gen + 1u) * nloc) {
            __builtin_amdgcn_fence(__ATOMIC_RELEASE, "agent");
            asm volatile("s_waitcnt vmcnt(0)" ::: "memory");
            const unsigned og = xb_add(&bar[XB_TOP], 1u);
            const unsigned tg = og / nx;
            if (og + 1u == (tg + 1u) * nx) xb_add(&bar[XB_TOPGEN], 1u);
            else XB_SPIN(xb_ld(&bar[XB_TOPGEN]) == tg, bar);
            __builtin_amdgcn_fence(__ATOMIC_ACQUIRE, "agent");
            xb_add(&bar[XB_XGEN(b.x)], 1u);
            asm volatile("s_waitcnt vmcnt(0)" ::: "memory");
        } else {
            XB_SPIN(xb_ld(&bar[XB_XGEN(b.x)]) == gen, bar);
            __builtin_amdgcn_fence(__ATOMIC_ACQUIRE, "agent");
            asm volatile("s_waitcnt vmcnt(0)" ::: "memory");
        }
    }
    __syncthreads();
}

__device__ __forceinline__ float wave_sum(float v) {
#pragma unroll
    for (int o = 1; o < 64; o <<= 1) v += __shfl_xor(v, o);
    return v;
}
__device__ __forceinline__ unsigned pkbf(float lo, float hi) { return pg8::cvt_pk_bf16(lo, hi); }

__device__ __forceinline__ void rms_row_bf16(const float* xrow, const float* gain, bf16* orow, int lane) {
    const f32x4* xr = (const f32x4*)xrow + lane; const f32x4* gr = (const f32x4*)gain + lane;
    f32x4 v[8]; float s = 0.f;
#pragma unroll
    for (int j = 0; j < 8; ++j) { v[j] = xr[64 * j]; s += (v[j].x * v[j].x + v[j].y * v[j].y) + (v[j].z * v[j].z + v[j].w * v[j].w); }
    const float rstd = 1.0f / sqrtf(wave_sum(s) * (1.f / DM) + EPS);
    v2u* o8 = (v2u*)orow + lane;
#pragma unroll
    for (int j = 0; j < 8; ++j) { const f32x4 g = gr[64 * j]; v2u w; w.x = pkbf(v[j].x * rstd * g.x, v[j].y * rstd * g.y); w.y = pkbf(v[j].z * rstd * g.z, v[j].w * rstd * g.w); o8[64 * j] = w; }
}
__device__ __forceinline__ void rms_row_f32(const float* xrow, const float* gain, float* orow, int lane) {
    const f32x4* xr = (const f32x4*)xrow + lane; const f32x4* gr = (const f32x4*)gain + lane;
    f32x4 v[8]; float s = 0.f;
#pragma unroll
    for (int j = 0; j < 8; ++j) { v[j] = xr[64 * j]; s += (v[j].x * v[j].x + v[j].y * v[j].y) + (v[j].z * v[j].z + v[j].w * v[j].w); }
    const float rstd = 1.0f / sqrtf(wave_sum(s) * (1.f / DM) + EPS);
    f32x4* o = (f32x4*)orow + lane;
#pragma unroll
    for (int j = 0; j < 8; ++j) { const f32x4 g = gr[64 * j]; o[64 * j] = v[j] * rstd * g; }
}

struct WtDesc { const float* W; const float* gn; bf16* dst; int N, ldk; };
__device__ __forceinline__ void wt_load(f32x4 (&v)[16], float (&gv)[16], const WtDesc& D, int lane) {
    const float* src = D.W + (size_t)(16 * (lane >> 4)) * D.N + 4 * (lane & 15);
#pragma unroll
    for (int i = 0; i < 16; ++i) v[i] = __builtin_nontemporal_load((const f32x4*)(src + (size_t)i * D.N));
    if (D.gn) { const f32x4* g4 = (const f32x4*)(D.gn + 16 * (lane >> 4));
#pragma unroll
        for (int i = 0; i < 4; ++i) { const f32x4 g = g4[i]; gv[4 * i] = g.x; gv[4 * i + 1] = g.y; gv[4 * i + 2] = g.z; gv[4 * i + 3] = g.w; } }
    else {
#pragma unroll
        for (int i = 0; i < 16; ++i) gv[i] = 1.0f; }
}
__device__ __forceinline__ void wt_proc_a(const f32x4 (&v)[16], const float (&gv)[16], LAS unsigned char* T, int lane) {
    LAS unsigned char* tw = T + (4 * (lane & 15)) * 144 + (16 * (lane >> 4)) * 2;
#pragma unroll
    for (int i4 = 0; i4 < 4; ++i4) { const f32x4 a = v[4 * i4] * gv[4 * i4], b = v[4 * i4 + 1] * gv[4 * i4 + 1], c = v[4 * i4 + 2] * gv[4 * i4 + 2], d = v[4 * i4 + 3] * gv[4 * i4 + 3];
#pragma unroll
        for (int cc = 0; cc < 4; ++cc) { v2u w; w.x = pkbf(a[cc], b[cc]); w.y = pkbf(c[cc], d[cc]); *(LAS v2u*)(tw + cc * 144 + i4 * 8) = w; } }
    LDS_WAIT(); asm volatile("" ::: "memory");
}
__device__ __forceinline__ void wt_proc_b(const WtDesc& D, LAS unsigned char* T, int lane) {
    const LAS unsigned char* tr = T + (lane >> 3) * 144 + (lane & 7) * 16;
    bf16* dst = D.dst + (size_t)(lane >> 3) * D.ldk + (lane & 7) * 8;
    v4u w[8];
#pragma unroll
    for (int r = 0; r < 8; ++r) w[r] = *(const LAS v4u*)(tr + r * 8 * 144);
#pragma unroll
    for (int r = 0; r < 8; ++r) __builtin_nontemporal_store(w[r], (v4u*)(dst + (size_t)(8 * r) * D.ldk));
    LDS_WAIT(); asm volatile("" ::: "memory");
}
__device__ __forceinline__ void wt_proc(const f32x4 (&v)[16], const float (&gv)[16], const WtDesc& D, LAS unsigned char* T, int lane) { wt_proc_a(v, gv, T, lane); wt_proc_b(D, T, lane); }
__device__ __forceinline__ void wt_item(const float* W, int N, int k0, int n0, bf16* wt0, int ldk, LAS unsigned char* T, int lane, const float* gain = nullptr) {
    WtDesc D; D.W = W + (size_t)k0 * N + n0; D.gn = gain ? gain + k0 : nullptr; D.dst = wt0; D.N = N; D.ldk = ldk;
    f32x4 v[16]; float gv[16]; wt_load(v, gv, D, lane); wt_proc(v, gv, D, T, lane);
}
constexpr int IT_WIN = (DM / 64) * (NIN / 64), IT_WGATE = (DM / 64) * (NGATE / 64), IT_PA = (1024 / 64) * (DM / 64), IT_PB = (512 / 64) * (DM / 64), IT_PC = IT_PB,
              IT_WOUT = (DM / 64) * (DM / 64), IT_FG = (DM / 64) * (DFF / 64), IT_FU = IT_FG, IT_FD = (DFF / 64) * (DM / 64);
constexpr int IT_E0 = IT_WIN, IT_E1 = IT_E0 + IT_WGATE, IT_E2 = IT_E1 + IT_PA, IT_E3 = IT_E2 + IT_PB, IT_E4 = IT_E3 + IT_PC, IT_E5 = IT_E4 + IT_WOUT, IT_E6 = IT_E5 + IT_FG, IT_E7 = IT_E6 + IT_FU, IT_E8 = IT_E7 + IT_FD;
struct Args {
    const float* in[20]; float* out; unsigned char* ws; int ph_lo, ph_hi, li, pad;
};
constexpr int PH_PRO = 0, PH_MEMKV = 1, PH_L0 = 2, PH_PER_LAYER = 7, PH_FINAL = PH_L0 + DEPTH * PH_PER_LAYER, PH_N = PH_FINAL + 1;
constexpr int CW_QUEUE = 150000;
constexpr int CW_SS = 262144;
static_assert((size_t)CW_SS * 4 + (size_t)9 * MTOK * 8 <= CTL_ZERO_BYTES && CW_BAR + 40 * XCD_BAR_WORDS <= CW_QUEUE, "CTL map");

#define CONV_DECODE(D_, it_, lw_) do { const int ci_ = (it_); const int clw_ = (lw_); \
        const float* W; int K, N, ldk, koff, r, swz; bf16* WT; int rowoff; const float* gn = nullptr; \
        if (ci_ < IT_E0)      { r = ci_;         W = INP(5) + (size_t)clw_ * DM * NIN;    K = DM;   N = NIN;   WT = P_WIN;  ldk = DM;  koff = 0;    rowoff = 0;   swz = -1; gn = INP(4) + clw_ * DM; } \
        else if (ci_ < IT_E1) { r = ci_ - IT_E0; W = INP(9) + (size_t)clw_ * DM * NGATE;  K = DM;   N = NGATE; WT = P_WIN;  ldk = DM;  koff = 0;    rowoff = NIN; swz = -1; gn = INP(4) + clw_ * DM; } \
        else if (ci_ < IT_E2) { r = ci_ - IT_E1; W = INP(11) + (size_t)clw_ * 1024 * DM;  K = 1024; N = DM;    WT = P_WPRJ; ldk = DM;  koff = 0;    rowoff = 0;   swz = -1; } \
        else if (ci_ < IT_E3) { r = ci_ - IT_E2; W = INP(12) + (size_t)clw_ * 512 * DM;   K = 512;  N = DM;    WT = P_WPRJ; ldk = DM;  koff = 1024; rowoff = 0;   swz = -1; } \
        else if (ci_ < IT_E4) { r = ci_ - IT_E3; W = INP(13) + (size_t)clw_ * 512 * DM;   K = 512;  N = DM;    WT = P_WPRJ; ldk = DM;  koff = 1536; rowoff = 0;   swz = -1; } \
        else if (ci_ < IT_E5) { r = ci_ - IT_E4; W = INP(14) + (size_t)clw_ * DM * DM;    K = DM;   N = DM;    WT = P_WOUT; ldk = DM;  koff = 0;    rowoff = 0;   swz = -1; } \
        else if (ci_ < IT_E6) { r = ci_ - IT_E5; W = INP(16) + (size_t)clw_ * DM * DFF;   K = DM;   N = DFF;   WT = P_WFF;  ldk = DM;  koff = 0;    rowoff = 0;   swz = 0; gn = INP(15) + clw_ * DM; } \
        else if (ci_ < IT_E7) { r = ci_ - IT_E6; W = INP(17) + (size_t)clw_ * DM * DFF;   K = DM;   N = DFF;   WT = P_WFF;  ldk = DM;  koff = 0;    rowoff = 0;   swz = 1; gn = INP(15) + clw_ * DM; } \
        else                 { r = ci_ - IT_E7; W = INP(18) + (size_t)clw_ * DFF * DM;   K = DFF;  N = DM;    WT = P_WDN;  ldk = DFF; koff = 0;    rowoff = 0;   swz = -1; } \
        const int nnb = N >> 6, kb = r / nnb, nb = r - kb * nnb, n0 = nb * 64, k0 = kb * 64;     \
        const int drow = swz < 0 ? (rowoff + n0) : ((n0 >> 7) * 256 + swz * 128 + (n0 & 127)); \
        (D_).W = W + (size_t)k0 * N + n0; (D_).gn = gn ? gn + k0 : nullptr; (D_).dst = WT + (size_t)drow * ldk + koff + k0; (D_).N = N; (D_).ldk = ldk; } while (0)
#define CONV_ITEM(it_, lw_) do { WtDesc D_; CONV_DECODE(D_, it_, lw_); f32x4 v_[16]; float g_[16]; wt_load(v_, g_, D_, lane); wt_proc(v_, g_, D_, Twave, lane); } while (0)

__global__ void __launch_bounds__(NWAVES * 64, 2) trunk_fwd(Args args) {
    extern __shared__ __attribute__((aligned(16))) unsigned char lds[];
    LAS unsigned char* ldsl = (LAS unsigned char*)lds;
    volatile LAS unsigned* MISC = (volatile LAS unsigned*)(ldsl + MISC_OFF);
    const int tid = threadIdx.x, wave = __builtin_amdgcn_readfirstlane(tid >> 6);
#define LANE() (att::ltid() & 63)
    const int G = gridDim.x; const int bx = blockIdx.x; const int vcu = (G % 8 == 0) ? (bx % 8) * (G / 8) + bx / 8 : bx;
    const int gw = vcu * NWAVES + wave, NGW = G * NWAVES;
    typedef const __attribute__((address_space(4))) Args* KArgs;
    unsigned long long ka_bits = (unsigned long long)__builtin_amdgcn_kernarg_segment_ptr();
#define KA() ({ asm volatile("" : "+s"(ka_bits)); (KArgs)ka_bits; })
#define WSP(off) ((unsigned char*)KA()->ws + (off))
#define INP(k) (KA()->in[k])
    unsigned* ctl = (unsigned*)WSP(WS_CTL);
    for (int u = tid; u < (LDS_BYTES - LDSCTL_OFF) / 4; u += NWAVES * 64) ((LAS unsigned*)(ldsl + LDSCTL_OFF))[u] = 0u;
    __syncthreads();
    XcdBarrier bar = xcd_barrier_post(ctl + CW_BAR + KA()->li * XCD_BAR_WORDS, MISC + 8);
    const int lo = KA()->ph_lo, hi = KA()->ph_hi;
#define IN(k) (lo <= (k) && (k) < hi)
#define SEAM(k) do { if (IN(k) && IN((k) + 1)) xcd_barrier(bar); } while (0)

#define P_X      ((float*)WSP(WS_X))
#define P_XB     ((bf16*)WSP(WS_H))
#define P_QKV    ((bf16*)WSP(WS_QKV))
#define P_HID    ((bf16*)WSP(WS_HID))
#define P_GATE   ((bf16*)WSP(WS_GATE))
#define P_OBUF   ((bf16*)WSP(WS_OBUF))
#define P_MRG    ((bf16*)WSP(WS_MRG))
#define P_OB3    ((bf16*)WSP(WS_OB3))
#define P_LSE    ((float*)WSP(WS_LSE))
#define P_MEMN   ((bf16*)WSP(WS_MEMN))
#define P_MEMKV  ((bf16*)WSP(WS_MEMKV))
#define P_WMEM   ((bf16*)WSP(WS_WMEM))
#define P_WIN    ((bf16*)WSP(WS_WIN))
#define P_WPRJ   ((bf16*)WSP(WS_WPRJ))
#define P_WOUT   ((bf16*)WSP(WS_WOUT))
#define P_WFF    ((bf16*)WSP(WS_WFF))
#define P_WDN    ((bf16*)WSP(WS_WDN))
#define P_SS(i)  ((unsigned long long*)((unsigned*)WSP(WS_CTL) + CW_SS) + (i) * MTOK)
    LAS unsigned char* Twave = ldsl + wave * 9216;

    if (IN(PH_PRO)) {
        const int lane = LANE();
        { const float* w_mem_kv = INP(8); bf16* WMEM = P_WMEM;
          for (int it = gw; it < DEPTH * (DM / 64) * (1024 / 64); it += NGW) { const int l = it >> 9, r = it & 511, kb = r >> 4, nb = r & 15;
              wt_item(w_mem_kv + (size_t)l * DM * 1024, 1024, kb * 64, nb * 64, WMEM + (size_t)(l * 1024 + nb * 64) * DM + kb * 64, DM, Twave, lane); } }
        { const float* mem = INP(1); const float* mem_norm = INP(3); bf16* MEMN = P_MEMN;
          for (int m = gw; m < NB * MEML; m += NGW) rms_row_bf16(mem + (size_t)m * DM, mem_norm, MEMN + (size_t)m * DM, lane); }
    }
    SEAM(PH_PRO);
    if (IN(PH_MEMKV)) {
        constexpr int NMU = (NB * MEML / 256) * (4096 / 256);
        { pg8::Gemm g{P_MEMN, P_WMEM, NB * MEML, 4096, DM}; pg8::StaticOrder S; S.init(NB * MEML, 4096, G, bx);
            pg8::EpiPlain E{P_MEMKV, 4096};
            pg8::gemm_phase<pg8::EpiPlain, pg8::StaticOrder, true, true>(ldsl, g, S, E); }
        const bool split = G > 2 * NMU;
        if (!split || bx >= NMU) {
            const int lane = LANE();
            const int tgw = split ? (bx - NMU) * NWAVES + wave : bx * NWAVES + wave, tngw = split ? (G - NMU) * NWAVES : G * NWAVES;
            for (int it = tgw; it < IT_E1; it += tngw) CONV_ITEM(it, 0);
            { const float* xin = INP(0); bf16* XB = P_XB; unsigned long long* ss0 = P_SS(0);
              for (int m = tgw; m < MTOK; m += tngw) { const f32x4* xr = (const f32x4*)(xin + (size_t)m * DM) + lane; v2u* o8 = (v2u*)(XB + (size_t)m * DM) + lane; float sq = 0.f;
#pragma unroll
                  for (int j = 0; j < 8; ++j) { const f32x4 v = xr[64 * j]; v2u w; w.x = pkbf(v.x, v.y); w.y = pkbf(v.z, v.w); o8[64 * j] = w;
                      const float r0 = pg8::bf_lo(w.x), r1 = pg8::bf_hi(w.x), r2 = pg8::bf_lo(w.y), r3 = pg8::bf_hi(w.y); sq += (r0 * r0 + r1 * r1) + (r2 * r2 + r3 * r3); }
                  sq = wave_sum(sq); if (lane == 0) ss0[m] = (unsigned long long)(sq * 1048576.0f + 0.5f); } }
        }
    }
    SEAM(PH_MEMKV);

    for (int l = 0; l < DEPTH; ++l) {
        const int pb = PH_L0 + l * PH_PER_LAYER;
        if (IN(pb + 0)) {
            pg8::Gemm g{P_XB, P_WIN, MTOK, NIN + NGATE, DM}; pg8::StaticOrder S; S.init(MTOK, NIN + NGATE, G, bx);
            pg8::EpiInGate E{P_QKV, P_GATE, INP(10) + (size_t)l * NGATE, P_SS(2 * l)};
            pg8::gemm_phase<pg8::EpiInGate, pg8::StaticOrder, true, true>(ldsl, g, S, E);
        }
        SEAM(pb + 0);
        if (IN(pb + 1)) {
            float lam, post;
            { const int lane = LANE(); const float* dl = INP(6) + (size_t)l * 256; const float s1 = wave_sum(dl[lane] * dl[64 + lane]), s2 = wave_sum(dl[128 + lane] * dl[192 + lane]);
              const float lam_init = 0.8f - 0.6f * expf(-0.3f * (float)l); const float lamv = expf(s1) - expf(s2) + lam_init;
              lam = __uint_as_float(__builtin_amdgcn_readfirstlane(__float_as_uint(lamv))); post = __uint_as_float(__builtin_amdgcn_readfirstlane(__float_as_uint(lam_init))); }
            constexpr int NCH = 340, IPC = 52, NLOC = IT_E8 - IT_E1;
            static_assert(NCH * IPC >= IT_E8, "conversion chunks cover every item");
            const int TI = NLOC + (l + 1 < DEPTH ? IT_E1 : 0);
            const int qx = bx & 7, ncx = (NCH - qx + 7) >> 3, QR = 64 + ncx;
            unsigned* qhead = ctl + CW_QUEUE + 64 * (l * 8 + qx);
            for (;;) {
                __syncthreads();
                if (tid == 0) MISC[16] = __hip_atomic_fetch_add(qhead, 1u, __ATOMIC_RELAXED, __HIP_MEMORY_SCOPE_AGENT);
                __syncthreads();
                const int u = __builtin_amdgcn_readfirstlane((int)MISC[16]);
                if (u >= QR + 64) break;
                if (u < QR) {
                    const int cbef = (u * ncx) / QR, cbef1 = ((u + 1) * ncx) / QR;
                    if (cbef1 > cbef) {
                        const int c = qx + 8 * cbef; const int lane = LANE();
                        int j = c * IPC + wave; const int jend = (c + 1) * IPC < TI ? (c + 1) * IPC : TI;
#define JDEC(D, jj) do { const int jj_ = (jj); if (jj_ < NLOC) CONV_DECODE(D, IT_E1 + jj_, l); else CONV_DECODE(D, jj_ - NLOC, l + 1); } while (0)
                        if (j < jend) {
                            WtDesc D; f32x4 v[16]; float gv[16];
                            JDEC(D, j); wt_load(v, gv, D, lane);
                            for (;;) {
                                const int j1 = j + 8; const bool h1 = j1 < jend;
                                WtDesc Dn; if (h1) JDEC(Dn, j1);
                                wt_proc_a(v, gv, Twave, lane);
                                if (h1) wt_load(v, gv, Dn, lane);
                                wt_proc_b(D, Twave, lane);
                                if (!h1) break;
                                D = Dn; j = j1;
                            }
                        }
#undef JDEC
                        LDS_WAIT();
                    } else {
                        const int al = u - cbef, au = (qx * 4 + (al >> 4)) * 16 + (al & 15);
                        const int chunk = au & 15, h = (au >> 4) & 7, b = au >> 7;
                        att::PolA P; P.init(P_QKV, P_OBUF, INP(7) + l * 128, lam, post, b, h, chunk * 128, INP(2), (char*)lds);
                        att::attn_unit<att::PolA>(P, (char*)lds);
                    }
                } else if (u < QR + 48) { {
                    const int su = qx * 48 + (u - QR); const int g_ = su % 3, r = su / 3, chunk = r & 7, hb = (r >> 3) & 3, b = r >> 5;
                    att::PolB P; P.init(P_QKV, P_OB3 + (size_t)g_ * MTOK * 512, P_LSE + (size_t)g_ * MTOK * 4, b, g_, hb, chunk * 256, INP(2), (char*)lds);
                    att::attn_unit<att::PolB>(P, (char*)lds); }
                } else { {
                    const int r = qx * 16 + (u - QR - 48), chunk = r & 7, h = (r >> 3) & 3, b = r >> 5;
                    att::PolC P; P.init(P_QKV, P_MEMKV + l * 1024, P_OBUF, b, h, chunk * 256);
                    att::attn_unit<att::PolC>(P, (char*)lds); }
                }
            }
        }
        SEAM(pb + 1);
        if (IN(pb + 2)) {
            const int lane = LANE();
            const float* LSE = P_LSE; const bf16* OB3 = P_OB3; bf16* OBUF = P_OBUF;
            for (int m = gw; m < MTOK; m += NGW) {
                const int hb = lane >> 4;
                const float l0 = LSE[(size_t)m * 4 + hb], l1 = LSE[(size_t)(MTOK + m) * 4 + hb], l2 = LSE[(size_t)(2 * MTOK + m) * 4 + hb];
                const float mx = fmaxf(l0, fmaxf(l1, l2));
                float a0 = __builtin_amdgcn_exp2f(l0 - mx), a1 = __builtin_amdgcn_exp2f(l1 - mx), a2 = __builtin_amdgcn_exp2f(l2 - mx);
                const float inv = 1.0f / (a0 + a1 + a2); a0 *= inv; a1 *= inv; a2 *= inv;
                const bf16* p0 = OB3 + (size_t)m * 512 + lane * 8;
                const v4u u = *(const v4u*)p0, v = *(const v4u*)(p0 + (size_t)MTOK * 512), w3 = *(const v4u*)(p0 + (size_t)2 * MTOK * 512);
#define CMB(x_) (pg8::bf_lo(u.x_) * a0 + pg8::bf_lo(v.x_) * a1 + pg8::bf_lo(w3.x_) * a2), (pg8::bf_hi(u.x_) * a0 + pg8::bf_hi(v.x_) * a1 + pg8::bf_hi(w3.x_) * a2)
                v4u w; w.x = pkbf(CMB(x)); w.y = pkbf(CMB(y)); w.z = pkbf(CMB(z)); w.w = pkbf(CMB(w));
#undef CMB
                *(v4u*)(OBUF + (size_t)m * DM + 1024 + lane * 8) = w;
            }
        }
        SEAM(pb + 2);
        if (IN(pb + 3)) {
            pg8::Gemm g{P_OBUF, P_WPRJ, MTOK, DM, DM}; pg8::StaticOrder S; S.init(MTOK, DM, G, bx);
            pg8::EpiProj E{P_GATE, P_MRG};
            pg8::gemm_phase<pg8::EpiProj, pg8::StaticOrder, true, true>(ldsl, g, S, E);
        }
        SEAM(pb + 3);
        if (IN(pb + 4)) {
            pg8::Gemm g{P_MRG, P_WOUT, MTOK, DM, DM}; pg8::StaticOrder S; S.init(MTOK, DM, G, bx);
            pg8::EpiResid E{(l == 0) ? INP(0) : (const float*)nullptr, P_XB, P_SS(2 * l + 1)};
            pg8::gemm_phase<pg8::EpiResid, pg8::StaticOrder, true, true>(ldsl, g, S, E);
        }
        SEAM(pb + 4);
        if (IN(pb + 5)) {
            pg8::Gemm g{P_XB, P_WFF, MTOK, 2 * DFF, DM}; pg8::StaticOrder S; S.init(MTOK, 2 * DFF, G, bx);
            pg8::EpiSwiGLU E{P_HID, P_SS(2 * l + 1)};
            pg8::gemm_phase<pg8::EpiSwiGLU, pg8::StaticOrder, true, true>(ldsl, g, S, E);
        }
        SEAM(pb + 5);
        if (IN(pb + 6)) {
            pg8::Gemm g{P_HID, P_WDN, MTOK, DM, DFF}; pg8::StaticOrder S; S.init(MTOK, DM, G, bx);
            pg8::EpiResid E{nullptr, P_XB, P_SS(2 * l + 2)};
            pg8::gemm_phase<pg8::EpiResid, pg8::StaticOrder, true, true>(ldsl, g, S, E);
        }
        SEAM(pb + 6);
    }
    if (IN(PH_FINAL)) {
        const int lane = LANE();
        const bf16* Xp = P_XB; const float* gn = INP(19); float* outp = KA()->out; const unsigned long long* ss = P_SS(8);
        for (int m = gw; m < MTOK; m += NGW) { const float rstd = 1.0f / sqrtf((float)ss[m] * (1.f / (DM * 1048576.0f)) + EPS);
            const v2u* xr = (const v2u*)(Xp + (size_t)m * DM) + lane; const f32x4* gr = (const f32x4*)gn + lane; f32x4* o = (f32x4*)(outp + (size_t)m * DM) + lane;
#pragma unroll
            for (int j = 0; j < 8; ++j) { const v2u p = xr[64 * j]; const f32x4 x = (f32x4){pg8::bf_lo(p.x), pg8::bf_hi(p.x), pg8::bf_lo(p.y), pg8::bf_hi(p.y)}; o[64 * j] = x * rstd * gr[64 * j]; } }
    }
#undef IN
#undef SEAM
}

extern "C" void kernel_launch(void* const* d_in, const int* in_sizes, int n_in, void* d_out, int out_size, void* d_ws, size_t ws_size, hipStream_t stream) {
    static int grid = 0;
    if (grid == 0) {
        if (n_in != 20 || out_size != MTOK * DM || ws_size < WS_END) { fprintf(stderr, "kernel_launch: unexpected shapes: n_in %d out %d ws %zu (need %zu)\n", n_in, out_size, ws_size, (size_t)WS_END); grid = -1; return; }
        int dev = 0, cus = 0, per_cu = 0;
        if (hipGetDevice(&dev) != hipSuccess || hipDeviceGetAttribute(&cus, hipDeviceAttributeMultiprocessorCount, dev) != hipSuccess) { grid = -1; return; }
        if (hipFuncSetAttribute((const void*)trunk_fwd, hipFuncAttributeMaxDynamicSharedMemorySize, LDS_BYTES) != hipSuccess) { fprintf(stderr, "kernel_launch: hipFuncSetAttribute failed\n"); grid = -1; return; }
        if (hipOccupancyMaxActiveBlocksPerMultiprocessor(&per_cu, (const void*)trunk_fwd, NWAVES * 64, LDS_BYTES) != hipSuccess || per_cu < 1)
            fprintf(stderr, "kernel_launch: occupancy query reports %d workgroups per CU\n", per_cu);
        (void)hipGetLastError();
        grid = cus;
    }
    if (grid < 0) return;
    if (hipMemsetAsync((char*)d_ws + WS_CTL, 0, CTL_ZERO_BYTES, stream) != hipSuccess) { fprintf(stderr, "kernel_launch: memset failed\n"); return; }
    Args a{};
    for (int i = 0; i < 20; ++i) a.in[i] = (const float*)d_in[i];
    a.out = (float*)d_out; a.ws = (unsigned char*)d_ws; a.pad = 0;
#if MK_PER_PHASE
    for (int p = 0; p < PH_N; ++p) { a.ph_lo = p; a.ph_hi = p + 1; a.li = p;
        hipLaunchKernelGGL(trunk_fwd, dim3(grid), dim3(NWAVES * 64), LDS_BYTES, stream, a); }
#else
    a.ph_lo = 0; a.ph_hi = PH_N; a.li = 0;
    hipLaunchKernelGGL(trunk_fwd, dim3(grid), dim3(NWAVES * 64), LDS_BYTES, stream, a);
#endif
    const hipError_t le = hipPeekAtLastError();
    if (le != hipSuccess) fprintf(stderr, "kernel_launch: launch failed: %s\n", hipGetErrorName(le));
}
```

```cpp
#include <hip/hip_runtime.h>
#include <cstdio>
#include <cstdint>


#ifndef MK_PER_PHASE
#define MK_PER_PHASE 0
#endif

namespace pg8 {
#define PG8_LAS __attribute__((address_space(3)))
typedef unsigned short bf16_t;
typedef short bf16x8 __attribute__((ext_vector_type(8)));
typedef float f32x4 __attribute__((ext_vector_type(4)));
typedef unsigned u32x4 __attribute__((ext_vector_type(4)));
constexpr int BM = 256, BK = 64, HALF = 128, HTB = HALF * BK * 2, STAGE_BYTES = 8 * HTB, NXCD = 8, WGM = 8;

__host__ __device__ __forceinline__ int lds_byte(int r, int c) { const int st = (r >> 4) * 2 + (c >> 5), rr = r & 15, cc = c & 31, ob = rr * 64 + cc * 2; return st * 1024 + (ob ^ (((ob >> 9) & 1) << 5)); }
__host__ __device__ __forceinline__ void stage_rc(int b, int& R, int& C) { const int st = b / 1024, sb = b % 1024, swz = sb ^ (((sb >> 9) & 1) << 5); R = (st >> 1) * 16 + swz / 64; C = (st & 1) * 32 + (swz % 64) / 2; }
__host__ __device__ __forceinline__ int perm32(int rho) { const int n = rho >> 4, i = rho & 15; return 8 * (i >> 2) + 4 * n + (i & 3); }

struct Unit { int pm, pn; };
struct Gemm { const bf16_t* A; const bf16_t* Bt; int M, N, K; };

struct StaticOrder {
    int nM, nN, nwg, G, c;
    __host__ __device__ void init(int M, int N, int G_, int c_) { nM = M / BM; nN = N / BM; nwg = nM * nN; G = G_; c = c_; }
    __host__ __device__ bool next(int i, Unit& u) const {
        const long L = (long)i * G + c; if (L >= nwg) return false;
        int wgid = (int)L; { const int q = nwg / NXCD, r = nwg % NXCD, xcd = wgid % NXCD, off = wgid / NXCD; wgid = (xcd < r ? xcd * (q + 1) : r * (q + 1) + (xcd - r) * q) + off; }
        const int nig = WGM * nN, gid = wgid / nig, fm = gid * WGM, gsz = (nM - fm) < WGM ? (nM - fm) : WGM;
        u.pm = fm + ((wgid % nig) % gsz); u.pn = (wgid % nig) / gsz; return true;
    }
    __device__ __forceinline__ void a_ready(const Unit&) const {}
    __device__ __forceinline__ void done(const Unit&) const {}
};

__device__ __forceinline__ unsigned cvt_pk_bf16(float lo, float hi) { unsigned r; asm volatile("v_cvt_pk_bf16_f32 %0, %1, %2" : "=v"(r) : "v"(lo), "v"(hi)); return r; }
__device__ __forceinline__ float bf_lo(unsigned w) { return __uint_as_float(w << 16); }
__device__ __forceinline__ float bf_hi(unsigned w) { return __uint_as_float(w & 0xffff0000u); }
__device__ __forceinline__ float sigmoidf_(float v) { return __builtin_amdgcn_rcpf(1.0f + __builtin_amdgcn_exp2f(-1.4426950408889634f * v)); }


struct EpiInGate {
    static constexpr bool PERM = true, AFTER_DRAIN = false, HAS_MID = false;
    bf16_t* qkv; bf16_t* gate; const float* bgate; const unsigned long long* ss;
    __device__ __forceinline__ void operator()(const f32x4 (&acc)[2][2][4][2], const Unit& u, int wr, int wc, int fr, int fq) const {
        const int row0 = u.pm * BM + wr * 64 + fr; int colt = u.pn * BM;
        const bool isg = colt >= 8192;
        if (isg) colt -= 8192;
        const int col0 = colt + wc * 32 + 8 * fq;
        f32x4 bv[2][2];
#pragma unroll
        for (int bj = 0; bj < 2; ++bj)
#pragma unroll
            for (int n = 0; n < 2; ++n) bv[bj][n] = isg ? *(const f32x4*)(bgate + col0 + bj * HALF + 4 * n) : (f32x4){0.f, 0.f, 0.f, 0.f};
        const int bb = (u.pm * BM) >> 11, s0 = (row0 & 2047);
#pragma unroll
        for (int ai = 0; ai < 2; ++ai)
#pragma unroll
            for (int m = 0; m < 4; ++m) {
                const float rs = __builtin_amdgcn_rsqf((float)ss[row0 + ai * HALF + m * 16] * (1.0f / (2048.0f * 1048576.0f)) + 1e-5f);
#pragma unroll
                for (int bj = 0; bj < 2; ++bj) { f32x4 v0 = acc[ai][bj][m][0] * rs + bv[bj][0], v1 = acc[ai][bj][m][1] * rs + bv[bj][1];
                    bf16_t* dst;
                    if (isg) { dst = gate + (size_t)(row0 + ai * HALF + m * 16) * 6144 + col0 + bj * HALF;
#pragma unroll
                        for (int i = 0; i < 4; ++i) { v0[i] = fmaxf(sigmoidf_(v0[i]), 1e-30f); v1[i] = fmaxf(sigmoidf_(v1[i]), 1e-30f); } }
                    else dst = qkv + (size_t)(((((colt >> 7) + bj) * 4 + bb) * 2048) + s0 + ai * HALF + m * 16) * 128 + wc * 32 + 8 * fq;
                    u32x4 w; w.x = cvt_pk_bf16(v0[0], v0[1]); w.y = cvt_pk_bf16(v0[2], v0[3]); w.z = cvt_pk_bf16(v1[0], v1[1]); w.w = cvt_pk_bf16(v1[2], v1[3]);
                    *(u32x4*)dst = w; } }
    }
};
struct EpiPlain {
    static constexpr bool PERM = true, AFTER_DRAIN = false, HAS_MID = false;
    bf16_t* O; int ldc;
    __device__ __forceinline__ void operator()(const f32x4 (&acc)[2][2][4][2], const Unit& u, int wr, int wc, int fr, int fq) const {
        const int row0 = u.pm * BM + wr * 64 + fr; const int col0 = u.pn * BM + wc * 32 + 8 * fq;
#pragma unroll
        for (int ai = 0; ai < 2; ++ai)
#pragma unroll
            for (int m = 0; m < 4; ++m) { bf16_t* rowp = O + (size_t)(row0 + ai * HALF + m * 16) * ldc + col0;
#pragma unroll
                for (int bj = 0; bj < 2; ++bj) { const f32x4 v0 = acc[ai][bj][m][0], v1 = acc[ai][bj][m][1];
                    u32x4 w; w.x = cvt_pk_bf16(v0[0], v0[1]); w.y = cvt_pk_bf16(v0[2], v0[3]); w.z = cvt_pk_bf16(v1[0], v1[1]); w.w = cvt_pk_bf16(v1[2], v1[3]);
                    *(u32x4*)(rowp + bj * HALF) = w; } }
    }
};
struct EpiProj {
    static constexpr bool PERM = true, AFTER_DRAIN = false, HAS_MID = true;
    const bf16_t* gate; bf16_t* merged;
    static __device__ __forceinline__ bool is_mid(int t) { return t == 16 || t == 24; }
    __device__ __forceinline__ void mid(f32x4 (&acc)[2][2][4][2], const Unit& u, int t, int wr, int wc, int fr, int fq) const {
        const int seg = (t == 16) ? 0 : 1;
        const int row0 = u.pm * BM + wr * 64 + fr; const int col0 = u.pn * BM + wc * 32 + 8 * fq;
        const bf16_t* gbase = gate + (size_t)row0 * 6144 + seg * 2048 + col0;
#pragma unroll
        for (int ai = 0; ai < 2; ++ai)
#pragma unroll
            for (int mh = 0; mh < 2; ++mh) {
                u32x4 a[2][2], b[2][2];
#pragma unroll
                for (int mm = 0; mm < 2; ++mm)
#pragma unroll
                    for (int bj = 0; bj < 2; ++bj) { const bf16_t* gp = gbase + (size_t)(ai * HALF + (mh * 2 + mm) * 16) * 6144 + bj * HALF; a[mm][bj] = *(const u32x4*)gp; b[mm][bj] = *(const u32x4*)(gp + 2048); }
#pragma unroll
                for (int mm = 0; mm < 2; ++mm)
#pragma unroll
                    for (int bj = 0; bj < 2; ++bj) { const int m = mh * 2 + mm; const u32x4 A = a[mm][bj], B = b[mm][bj];
                        f32x4 r0, r1;
                        r0[0] = bf_lo(A.x) * __builtin_amdgcn_rcpf(bf_lo(B.x)); r0[1] = bf_hi(A.x) * __builtin_amdgcn_rcpf(bf_hi(B.x));
                        r0[2] = bf_lo(A.y) * __builtin_amdgcn_rcpf(bf_lo(B.y)); r0[3] = bf_hi(A.y) * __builtin_amdgcn_rcpf(bf_hi(B.y));
                        r1[0] = bf_lo(A.z) * __builtin_amdgcn_rcpf(bf_lo(B.z)); r1[1] = bf_hi(A.z) * __builtin_amdgcn_rcpf(bf_hi(B.z));
                        r1[2] = bf_lo(A.w) * __builtin_amdgcn_rcpf(bf_lo(B.w)); r1[3] = bf_hi(A.w) * __builtin_amdgcn_rcpf(bf_hi(B.w));
                        acc[ai][bj][m][0] = acc[ai][bj][m][0] * r0; acc[ai][bj][m][1] = acc[ai][bj][m][1] * r1; }
                __builtin_amdgcn_sched_barrier(0);
            }
    }
    __device__ __forceinline__ void operator()(const f32x4 (&acc)[2][2][4][2], const Unit& u, int wr, int wc, int fr, int fq) const {
        const int row0 = u.pm * BM + wr * 64 + fr; const int col0 = u.pn * BM + wc * 32 + 8 * fq;
#pragma unroll
        for (int ai = 0; ai < 2; ++ai)
#pragma unroll
            for (int m = 0; m < 4; ++m) { const size_t r = (size_t)(row0 + ai * HALF + m * 16); const bf16_t* gp = gate + r * 6144 + 2 * 2048 + col0; bf16_t* rowp = merged + r * 2048 + col0;
#pragma unroll
                for (int bj = 0; bj < 2; ++bj) { const u32x4 g = *(const u32x4*)(gp + bj * HALF); const f32x4 v0 = acc[ai][bj][m][0], v1 = acc[ai][bj][m][1];
                    u32x4 w; w.x = cvt_pk_bf16(v0[0] * bf_lo(g.x), v0[1] * bf_hi(g.x)); w.y = cvt_pk_bf16(v0[2] * bf_lo(g.y), v0[3] * bf_hi(g.y));
                    w.z = cvt_pk_bf16(v1[0] * bf_lo(g.z), v1[1] * bf_hi(g.z)); w.w = cvt_pk_bf16(v1[2] * bf_lo(g.w), v1[3] * bf_hi(g.w));
                    *(u32x4*)(rowp + bj * HALF) = w; } }
    }
};
struct EpiResid {
    static constexpr bool PERM = true, AFTER_DRAIN = false, HAS_MID = false;
    const float* base32; bf16_t* xb; unsigned long long* ss;
    __device__ __forceinline__ void operator()(const f32x4 (&acc)[2][2][4][2], const Unit& u, int wr, int wc, int fr, int fq) const {
        const int row0 = u.pm * BM + wr * 64 + fr; const int col0 = u.pn * BM + wc * 32 + 8 * fq;
#pragma unroll
        for (int ai = 0; ai < 2; ++ai)
#pragma unroll
            for (int m = 0; m < 4; ++m) { const int row = row0 + ai * HALF + m * 16; const size_t off = (size_t)row * 2048 + col0; float sq = 0.f;
#pragma unroll
                for (int bj = 0; bj < 2; ++bj) { f32x4 b0, b1;
                    if (base32) { b0 = *(const f32x4*)(base32 + off + bj * HALF); b1 = *(const f32x4*)(base32 + off + bj * HALF + 4); }
                    else { const u32x4 p = *(const u32x4*)(xb + off + bj * HALF); b0 = (f32x4){bf_lo(p.x), bf_hi(p.x), bf_lo(p.y), bf_hi(p.y)}; b1 = (f32x4){bf_lo(p.z), bf_hi(p.z), bf_lo(p.w), bf_hi(p.w)}; }
                    const f32x4 v0 = b0 + acc[ai][bj][m][0], v1 = b1 + acc[ai][bj][m][1];
                    u32x4 w; w.x = cvt_pk_bf16(v0[0], v0[1]); w.y = cvt_pk_bf16(v0[2], v0[3]); w.z = cvt_pk_bf16(v1[0], v1[1]); w.w = cvt_pk_bf16(v1[2], v1[3]);
                    *(u32x4*)(xb + off + bj * HALF) = w;
                    const float r0 = bf_lo(w.x), r1 = bf_hi(w.x), r2 = bf_lo(w.y), r3 = bf_hi(w.y), r4 = bf_lo(w.z), r5 = bf_hi(w.z), r6 = bf_lo(w.w), r7 = bf_hi(w.w);
                    sq += ((r0 * r0 + r1 * r1) + (r2 * r2 + r3 * r3)) + ((r4 * r4 + r5 * r5) + (r6 * r6 + r7 * r7)); }
                sq += __shfl_xor(sq, 16); sq += __shfl_xor(sq, 32);
                if (fq == 0) (void)__hip_atomic_fetch_add(ss + row, (unsigned long long)(sq * 1048576.0f + 0.5f), __ATOMIC_RELAXED, __HIP_MEMORY_SCOPE_AGENT); }
    }
};
struct EpiSwiGLU {
    static constexpr bool PERM = true, AFTER_DRAIN = false, HAS_MID = false;
    bf16_t* hid; const unsigned long long* ss;
    __device__ __forceinline__ void operator()(const f32x4 (&acc)[2][2][4][2], const Unit& u, int wr, int wc, int fr, int fq) const {
        const int row0 = u.pm * BM + wr * 64 + fr; const int col0 = u.pn * HALF + wc * 32 + 8 * fq;
#pragma unroll
        for (int ai = 0; ai < 2; ++ai)
#pragma unroll
            for (int m = 0; m < 4; ++m) { bf16_t* rowp = hid + (size_t)(row0 + ai * HALF + m * 16) * 5632 + col0;
                f32x4 h0, h1; const float rs = __builtin_amdgcn_rsqf((float)ss[row0 + ai * HALF + m * 16] * (1.0f / (2048.0f * 1048576.0f)) + 1e-5f);
#pragma unroll
                for (int i = 0; i < 4; ++i) { const float g0 = acc[ai][0][m][0][i] * rs, g1 = acc[ai][0][m][1][i] * rs;
                    h0[i] = g0 * sigmoidf_(g0) * (acc[ai][1][m][0][i] * rs); h1[i] = g1 * sigmoidf_(g1) * (acc[ai][1][m][1][i] * rs); }
                u32x4 w; w.x = cvt_pk_bf16(h0[0], h0[1]); w.y = cvt_pk_bf16(h0[2], h0[3]); w.z = cvt_pk_bf16(h1[0], h1[1]); w.w = cvt_pk_bf16(h1[2], h1[3]);
                *(u32x4*)rowp = w; }
    }
};

template <class Epi, class Sched, bool ALIGN_EPI = false, bool SP2 = false>
__device__ __forceinline__ void gemm_phase(PG8_LAS unsigned char* lds, const Gemm g, const Sched& S, const Epi& E) {
    int tid = threadIdx.x; asm volatile("" : "+v"(tid));
    const int wid = __builtin_amdgcn_readfirstlane(tid >> 6), lane = tid & 63, wr = wid >> 2, wc = wid & 3, fr = lane & 15, fq = lane >> 4;
    const int K = g.K, nt = K / BK;
    unsigned voffA[2], voffB[2];
#pragma unroll
    for (int i = 0; i < 2; ++i) { int R, C; stage_rc(tid * 16 + i * 8192, R, C); const int Rb = Epi::PERM ? ((R & ~31) + perm32(R & 31)) : R;
        voffA[i] = (unsigned)(R * K + C) * 2u; voffB[i] = (unsigned)(Rb * K + C) * 2u; }
    const size_t kstep = (size_t)(BK * 2);
    const size_t hstep = (size_t)HALF * K * 2;
    const size_t tstep = 2 * hstep;
    const unsigned ldsw = (unsigned)wid * 1024u;
    const int aoff = lds_byte(wr * 64 + fr, fq * 8), boff = lds_byte(wc * 32 + fr, fq * 8);
#define PG8_SA(b, h) (((b) * 2 + (h)) * HTB)
#define PG8_SB(b, h) ((4 + (b) * 2 + (h)) * HTB)
#define PG8_STAGE(bufoff, gbase, voff) do { _Pragma("unroll") for (int _i = 0; _i < 2; ++_i) \
        __builtin_amdgcn_global_load_lds((const unsigned*)((const char*)(gbase) + (voff)[_i]), (PG8_LAS unsigned*)(lds + (bufoff) + ldsw + _i * 8192), 16, 0, 0); } while (0)
#define PG8_LDA(dst, b, h) do { _Pragma("unroll") for (int m = 0; m < 4; ++m) _Pragma("unroll") for (int k = 0; k < 2; ++k) dst[m][k] = *(const PG8_LAS bf16x8*)(lds + PG8_SA(b, h) + aoff + m * 2048 + k * 1024); } while (0)
#define PG8_LDB(dst, b, h) do { _Pragma("unroll") for (int n = 0; n < 2; ++n) _Pragma("unroll") for (int k = 0; k < 2; ++k) dst[n][k] = *(const PG8_LAS bf16x8*)(lds + PG8_SB(b, h) + boff + n * 2048 + k * 1024); } while (0)
#define PG8_MMA(ai, bj, At, Bt) do { __builtin_amdgcn_s_setprio(1); _Pragma("unroll") for (int m = 0; m < 4; ++m) _Pragma("unroll") for (int n = 0; n < 2; ++n) _Pragma("unroll") for (int k = 0; k < 2; ++k) \
        acc[ai][bj][m][n] = __builtin_amdgcn_mfma_f32_16x16x32_bf16(Bt[n][k], At[m][k], acc[ai][bj][m][n], 0, 0, 0); __builtin_amdgcn_s_setprio(0); } while (0)
#define PG8_WAIT_V(n) asm volatile("s_waitcnt vmcnt(" #n ")" ::: "memory")
#define PG8_WAIT_L(n) asm volatile("s_waitcnt lgkmcnt(" #n ")" ::: "memory")
#define PG8_BAR __builtin_amdgcn_s_barrier()
#define PG8_SCHED __builtin_amdgcn_sched_barrier(0)
    Unit cur, nxt; int ui = 0;
    if (!S.next(0, cur)) return;
    f32x4 acc[2][2][4][2];
#pragma unroll
    for (int a = 0; a < 2; ++a)
#pragma unroll
        for (int b = 0; b < 2; ++b)
#pragma unroll
            for (int m = 0; m < 4; ++m)
#pragma unroll
                for (int n = 0; n < 2; ++n) acc[a][b][m][n] = (f32x4){0.f, 0.f, 0.f, 0.f};
    bf16x8 At[4][2], B0[2][2], B1[2][2];
    const char* cA = (const char*)g.A + (size_t)cur.pm * tstep; const char* cB = (const char*)g.Bt + (size_t)cur.pn * tstep;
    S.a_ready(cur);
    if constexpr (SP2) {
        PG8_STAGE(PG8_SB(0, 0), cB, voffB); PG8_STAGE(PG8_SB(0, 1), cB + hstep, voffB); PG8_STAGE(PG8_SA(0, 0), cA, voffA); PG8_STAGE(PG8_SA(0, 1), cA + hstep, voffA);
        if (wr == 1) PG8_BAR;
        PG8_WAIT_V(2); PG8_BAR;
        PG8_STAGE(PG8_SB(1, 0), cB + kstep, voffB); PG8_STAGE(PG8_SA(1, 0), cA + kstep, voffA); PG8_STAGE(PG8_SB(1, 1), cB + hstep + kstep, voffB);
        PG8_WAIT_V(6); PG8_BAR;
    } else {
        PG8_STAGE(PG8_SB(0, 0), cB, voffB); PG8_STAGE(PG8_SA(0, 0), cA, voffA); PG8_STAGE(PG8_SB(0, 1), cB + hstep, voffB); PG8_STAGE(PG8_SA(0, 1), cA + hstep, voffA);
        if (wr == 1) PG8_BAR;
        PG8_WAIT_V(4); PG8_BAR;
        PG8_STAGE(PG8_SB(1, 0), cB + kstep, voffB); PG8_STAGE(PG8_SA(1, 0), cA + kstep, voffA); PG8_STAGE(PG8_SB(1, 1), cB + hstep + kstep, voffB);
        PG8_WAIT_V(6); PG8_BAR;
    }
    for (;;) {
        const bool has_next = S.next(ui + 1, nxt);
        const char* nA = has_next ? (const char*)g.A + (size_t)nxt.pm * tstep : cA; const char* nB = has_next ? (const char*)g.Bt + (size_t)nxt.pn * tstep : cB;
        for (int t = 0; t < nt; t += 2) {
            const bool last = (t == nt - 2);
            const char* a1 = cA + (size_t)(t + 1) * kstep;
            const char* a2 = last ? nA : cA + (size_t)(t + 2) * kstep; const char* b2 = last ? nB : cB + (size_t)(t + 2) * kstep;
            const char* a3 = a2 + kstep; const char* b3 = b2 + kstep;
            if (last && has_next) S.a_ready(nxt);
            if constexpr (Epi::HAS_MID) { if (Epi::is_mid(t)) E.mid(acc, cur, t, wr, wc, fr, fq); }
            if constexpr (SP2) {
            PG8_LDB(B0, 0, 0); PG8_LDB(B1, 0, 1); PG8_SCHED; PG8_LDA(At, 0, 0); PG8_STAGE(PG8_SA(1, 1), a1 + hstep, voffA);
            PG8_WAIT_V(8); PG8_WAIT_L(0); PG8_BAR; PG8_MMA(0, 0, At, B0); PG8_MMA(0, 1, At, B1); PG8_BAR; PG8_SCHED;
            PG8_LDA(At, 0, 1); PG8_STAGE(PG8_SB(0, 0), b2, voffB); PG8_STAGE(PG8_SB(0, 1), b2 + hstep, voffB); PG8_STAGE(PG8_SA(0, 0), a2, voffA);
            PG8_WAIT_V(8); PG8_WAIT_L(0); PG8_BAR; PG8_MMA(1, 0, At, B0); PG8_MMA(1, 1, At, B1); PG8_BAR; PG8_SCHED;
            PG8_LDB(B0, 1, 0); PG8_LDB(B1, 1, 1); PG8_SCHED; PG8_LDA(At, 1, 0); PG8_STAGE(PG8_SA(0, 1), a2 + hstep, voffA);
            PG8_WAIT_V(8); PG8_WAIT_L(0); PG8_BAR; PG8_MMA(0, 0, At, B0); PG8_MMA(0, 1, At, B1); PG8_BAR; PG8_SCHED;
            PG8_LDA(At, 1, 1); PG8_STAGE(PG8_SB(1, 0), b3, voffB); PG8_STAGE(PG8_SB(1, 1), b3 + hstep, voffB); PG8_STAGE(PG8_SA(1, 0), a3, voffA);
            PG8_WAIT_V(8); PG8_WAIT_L(0); PG8_BAR; PG8_MMA(1, 0, At, B0); PG8_MMA(1, 1, At, B1); PG8_BAR; PG8_SCHED;
            } else {
            PG8_LDB(B0, 0, 0); PG8_SCHED; PG8_LDA(At, 0, 0); PG8_STAGE(PG8_SA(1, 1), a1 + hstep, voffA);
            PG8_WAIT_L(8); PG8_BAR; PG8_WAIT_L(0); PG8_MMA(0, 0, At, B0); PG8_BAR; PG8_SCHED;
            PG8_LDB(B1, 0, 1); PG8_STAGE(PG8_SB(0, 0), b2, voffB);
            PG8_BAR; PG8_WAIT_L(0); PG8_MMA(0, 1, At, B1); PG8_BAR;
            PG8_LDA(At, 0, 1); PG8_STAGE(PG8_SA(0, 0), a2, voffA);
            PG8_BAR; PG8_WAIT_L(0); PG8_MMA(1, 0, At, B0); PG8_BAR; PG8_SCHED;
            PG8_STAGE(PG8_SB(0, 1), b2 + hstep, voffB);
            PG8_WAIT_V(6); PG8_BAR; PG8_MMA(1, 1, At, B1); PG8_BAR;
            PG8_LDB(B0, 1, 0); PG8_SCHED; PG8_LDA(At, 1, 0); PG8_STAGE(PG8_SA(0, 1), a2 + hstep, voffA);
            PG8_WAIT_L(8); PG8_BAR; PG8_WAIT_L(0); PG8_MMA(0, 0, At, B0); PG8_BAR; PG8_SCHED;
            PG8_LDB(B1, 1, 1); PG8_STAGE(PG8_SB(1, 0), b3, voffB);
            PG8_BAR; PG8_WAIT_L(0); PG8_MMA(0, 1, At, B1); PG8_BAR;
            PG8_LDA(At, 1, 1); PG8_STAGE(PG8_SA(1, 0), a3, voffA);
            PG8_BAR; PG8_WAIT_L(0); PG8_MMA(1, 0, At, B0); PG8_BAR; PG8_SCHED;
            PG8_STAGE(PG8_SB(1, 1), b3 + hstep, voffB);
            PG8_WAIT_V(6); PG8_BAR; PG8_MMA(1, 1, At, B1); PG8_BAR;
            }
        }
        if constexpr (ALIGN_EPI) { if (wr == 0) PG8_BAR; }
        if constexpr (!Epi::AFTER_DRAIN) { E(acc, cur, wr, wc, fr, fq); S.done(cur); }
        if (!has_next) break;
#pragma unroll
        for (int a = 0; a < 2; ++a)
#pragma unroll
            for (int b = 0; b < 2; ++b)
#pragma unroll
                for (int m = 0; m < 4; ++m)
#pragma unroll
                    for (int n = 0; n < 2; ++n) acc[a][b][m][n] = (f32x4){0.f, 0.f, 0.f, 0.f};
        cur = nxt; cA = nA; cB = nB; ++ui;
        if constexpr (ALIGN_EPI) { if (wr == 1) PG8_BAR; }
    }
    PG8_WAIT_V(0);
    if constexpr (!ALIGN_EPI) { if (wr == 0) PG8_BAR; }
    PG8_BAR;
#undef PG8_SA
#undef PG8_SB
#undef PG8_STAGE
#undef PG8_LDA
#undef PG8_LDB
#undef PG8_MMA
#undef PG8_WAIT_V
#undef PG8_WAIT_L
#undef PG8_BAR
#undef PG8_SCHED
}
}

constexpr int DM = 2048, NB = 4, SEQ = 2048, DEPTH = 4, MTOK = NB * SEQ;
constexpr int MEML = 256, NIN = 8192, NGATE = 6144, DFF = 5632;
constexpr float EPS = 1e-5f;
constexpr float LOG2E = 1.4426950408889634f;
#define QKV_AT(b_, s_, col_) ((size_t)(((((col_) >> 7) * NB + (b_)) * SEQ + (s_))) * 128 + ((col_) & 127))
constexpr int C_QA = 0, C_KA = 1024, C_VA = 2048, C_QB = 3072, C_KB = 4608, C_VB = 6144, C_QC = 7680;

typedef unsigned short bf16;
typedef unsigned v4u __attribute__((ext_vector_type(4)));
typedef unsigned v2u __attribute__((ext_vector_type(2)));
typedef float f32x4 __attribute__((ext_vector_type(4)));
#define LAS __attribute__((address_space(3)))

namespace att {
__device__ __forceinline__ int ltid() { int t = threadIdx.x; asm volatile("" : "+v"(t)); return t; }
using bf16x8 = __attribute__((ext_vector_type(8))) short;
using s16x4  = __attribute__((ext_vector_type(4))) short;
using f32x16 = __attribute__((ext_vector_type(16))) float;
using u32x4  = __attribute__((ext_vector_type(4))) unsigned;
constexpr int NW = 8, QBLK = 32, KVBLK = 64;
constexpr int SHM_V = 16384, SHM_K = 16384;
constexpr int OFF_V = 0, OFF_K = 32768, OFF_WS = 65536, OFF_TAB = 65536 + 2048;
constexpr float THR2 = 11.5f;
#define KSWZ(row, colB) ((row) * 256 + ((colB) ^ (((row) & 7) << 4)))
#define SBAR() __builtin_amdgcn_sched_barrier(0)
__device__ __forceinline__ int crow(int r, int hi) { return (r & 3) + 8 * (r >> 2) + 4 * hi; }
__device__ __forceinline__ unsigned cvtpk(float lo, float hi) { unsigned r; asm volatile("v_cvt_pk_bf16_f32 %0, %1, %2" : "=v"(r) : "v"(lo), "v"(hi)); return r; }
__device__ __forceinline__ bf16x8 ld8(const bf16* p) { return *reinterpret_cast<const bf16x8*>(p); }

__device__ __forceinline__ void partialSM(f32x16& p0, f32x16& p1, float& m_reg, float& mn, float& alpha) {
  float pmax = p0[0];
#pragma unroll
  for (int r = 1; r < 16; ++r) pmax = fmaxf(pmax, p0[r]);
#pragma unroll
  for (int r = 0; r < 16; ++r) pmax = fmaxf(pmax, p1[r]);
  { auto rr = __builtin_amdgcn_permlane32_swap(__float_as_uint(pmax), __float_as_uint(pmax), false, false);
    pmax = fmaxf(__uint_as_float(rr[0]), __uint_as_float(rr[1])); }
  if (__builtin_expect(__all(pmax - m_reg <= THR2), 1)) { mn = m_reg; alpha = 1.f; }
  else { mn = fmaxf(m_reg, pmax); alpha = __builtin_amdgcn_exp2f(m_reg - mn); m_reg = mn; }
#pragma unroll
  for (int r = 0; r < 16; ++r) p0[r] = p0[r] - mn;
#pragma unroll
  for (int r = 0; r < 16; ++r) p1[r] = p1[r] - mn;
#pragma unroll
  for (int r = 0; r < 16; ++r) p0[r] = __builtin_amdgcn_exp2f(p0[r]);
}
__device__ __forceinline__ void finishSM(f32x16& p0, f32x16& p1, float alpha, float& l_reg, bf16x8& pa0, bf16x8& pa1, bf16x8& pa2, bf16x8& pa3) {
#pragma unroll
  for (int r = 0; r < 16; ++r) p1[r] = __builtin_amdgcn_exp2f(p1[r]);
  float ps = 0;
#pragma unroll
  for (int r = 0; r < 16; ++r) ps += p0[r];
#pragma unroll
  for (int r = 0; r < 16; ++r) ps += p1[r];
  { auto rr = __builtin_amdgcn_permlane32_swap(__float_as_uint(ps), __float_as_uint(ps), false, false);
    ps = __uint_as_float(rr[0]) + __uint_as_float(rr[1]); }
  l_reg = l_reg * alpha + ps;
#define PK4(P, BASE, OUT) do { unsigned a0 = cvtpk(P[BASE + 0], P[BASE + 1]), a1 = cvtpk(P[BASE + 2], P[BASE + 3]);   \
    unsigned b0 = cvtpk(P[BASE + 4], P[BASE + 5]), b1 = cvtpk(P[BASE + 6], P[BASE + 7]);                              \
    auto r0 = __builtin_amdgcn_permlane32_swap(a0, b0, false, false); auto r1 = __builtin_amdgcn_permlane32_swap(a1, b1, false, false); \
    u32x4 w = {r0[0], r1[0], r0[1], r1[1]}; OUT = *reinterpret_cast<bf16x8*>(&w); } while (0)
  PK4(p0, 0, pa0); PK4(p0, 8, pa1); PK4(p1, 0, pa2); PK4(p1, 8, pa3);
#undef PK4
}
template <int ND> __device__ __forceinline__ void qkt(f32x16& p0, f32x16& p1, const bf16* Ks, const bf16x8* qr, int doff, int r32, int hi) {
  p0 = f32x16{}; p1 = f32x16{};
#pragma unroll
  for (int d0 = 0; d0 < ND; ++d0) { const int cb = ((doff + d0) * 16 + hi * 8) * 2;
    bf16x8 b0 = *reinterpret_cast<const bf16x8*>((const char*)Ks + KSWZ(r32, cb));
    bf16x8 b1 = *reinterpret_cast<const bf16x8*>((const char*)Ks + KSWZ(32 + r32, cb));
    p0 = __builtin_amdgcn_mfma_f32_32x32x16_bf16(b0, qr[d0], p0, 0, 0, 0);
    p1 = __builtin_amdgcn_mfma_f32_32x32x16_bf16(b1, qr[d0], p1, 0, 0, 0); }
}
__device__ __forceinline__ int v_st(int k, int c) { const int kk = (k & ~0xC) | ((k & 4) << 1) | ((k & 8) >> 1); return ((kk >> 3) * 4 + (c >> 5)) * 512 + ((kk & 7) * 32 + (c & 31)) * 2; }
__device__ __forceinline__ int v_rd_base(int lane) { return ((lane & 3) << 3) | (((lane >> 2) & 3) << 6) | (((lane >> 4) & 1) << 5) | (((lane >> 5) & 1) << 8); }
constexpr int v_rd_off(int d0, int ks, int half) { return d0 * 512 + ks * 4096 + half * 2048; }
template <int OFF> __device__ __forceinline__ s16x4 tr_read(int vb) {
  s16x4 r; asm volatile("ds_read_b64_tr_b16 %0, %1 offset:%2" : "=&v"(r) : "v"(vb), "i"(OFF) : "memory"); return r;
}
template <int D0> __device__ __forceinline__ void pv_one(f32x16& od, int vb, bf16x8 pa0, bf16x8 pa1, bf16x8 pa2, bf16x8 pa3) {
  const s16x4 l0 = tr_read<v_rd_off(D0, 0, 0)>(vb), h0 = tr_read<v_rd_off(D0, 0, 1)>(vb), l1 = tr_read<v_rd_off(D0, 1, 0)>(vb), h1 = tr_read<v_rd_off(D0, 1, 1)>(vb);
  const s16x4 l2 = tr_read<v_rd_off(D0, 2, 0)>(vb), h2 = tr_read<v_rd_off(D0, 2, 1)>(vb), l3 = tr_read<v_rd_off(D0, 3, 0)>(vb), h3 = tr_read<v_rd_off(D0, 3, 1)>(vb);
  asm volatile("s_waitcnt lgkmcnt(0)" ::: "memory"); SBAR();
#define PK(L, H) (bf16x8){L[0], L[1], L[2], L[3], H[0], H[1], H[2], H[3]}
  od = __builtin_amdgcn_mfma_f32_32x32x16_bf16(pa0, PK(l0, h0), od, 0, 0, 0);
  od = __builtin_amdgcn_mfma_f32_32x32x16_bf16(pa1, PK(l1, h1), od, 0, 0, 0);
  od = __builtin_amdgcn_mfma_f32_32x32x16_bf16(pa2, PK(l2, h2), od, 0, 0, 0);
  od = __builtin_amdgcn_mfma_f32_32x32x16_bf16(pa3, PK(l3, h3), od, 0, 0, 0);
#undef PK
}
__device__ __forceinline__ void pv_d0(f32x16* o, int vb, bf16x8 pa0, bf16x8 pa1, bf16x8 pa2, bf16x8 pa3) {
  pv_one<0>(o[0], vb, pa0, pa1, pa2, pa3); pv_one<1>(o[1], vb, pa0, pa1, pa2, pa3); pv_one<2>(o[2], vb, pa0, pa1, pa2, pa3); pv_one<3>(o[3], vb, pa0, pa1, pa2, pa3);
}

__device__ __forceinline__ int rel_bucket(int rel) {
  const int n = rel < 0 ? -rel : rel;
  const int v = n < 8 ? n : (n < 15 ? 8 : (n < 27 ? 9 : (n < 50 ? 10 : (n < 91 ? 11 : (n < 166 ? 12 : (n < 305 ? 13 : (n < 559 ? 14 : 15)))))));
  return (rel > 0 ? 16 : 0) + v;
}

template <class P> __device__ __forceinline__ void attn_unit(P& pol, char* lds) {
  const int tid = ltid(), wid = tid >> 6, lane = tid & 63, r32 = lane & 31, hi = lane >> 5;
  bf16* V_lds = (bf16*)(lds + OFF_V); bf16* K_lds = (bf16*)(lds + OFF_K);
  float* ws = (float*)(lds + OFF_WS) + wid * 64; float* li_l = ws; float* al_l = ws + 32;
  float m_reg = -1e30f, l_reg = 0; f32x16 o[4] = {}; bf16x8 qr[P::ND];
  const bf16* Qw = pol.qptr() + hi * 8;
#pragma unroll
  for (int d0 = 0; d0 < P::ND; ++d0) qr[d0] = ld8(Qw + d0 * 16);
  const int sr = tid >> 4, sc = (tid & 15) * 8, vst0 = v_st(sr, sc), vst1 = v_st(32 + sr, sc);
  const int vb0 = (int)(uintptr_t)V_lds + v_rd_base(lane);
  const int doff = pol.doff();
  struct { bf16x8 vs0, vs1, ks0, ks1; } sr_[1];
#define SLOAD(i, t) do { sr_[i].vs0 = ld8(pol.vrow((t), sr) + sc); sr_[i].vs1 = ld8(pol.vrow((t), 32 + sr) + sc); \
    sr_[i].ks0 = ld8(pol.krow((t), sr) + sc); sr_[i].ks1 = ld8(pol.krow((t), 32 + sr) + sc); } while (0)
#define SWRITE(b, i) do { *(bf16x8*)((char*)V_lds + (b) * SHM_V + vst0) = sr_[i].vs0;          \
    *(bf16x8*)((char*)V_lds + (b) * SHM_V + vst1) = sr_[i].vs1; int kc = sc * 2;               \
    *(bf16x8*)((char*)K_lds + (b) * SHM_K + KSWZ(sr, kc)) = sr_[i].ks0;                       \
    *(bf16x8*)((char*)K_lds + (b) * SHM_K + KSWZ(32 + sr, kc)) = sr_[i].ks1; } while (0)
#define RESC(a) do { if (__any((a) < 1.f)) { if (hi == 0) al_l[r32] = (a); asm volatile("s_waitcnt lgkmcnt(0)" ::: "memory"); \
    _Pragma("unroll") for (int d = 0; d < 4; ++d) _Pragma("unroll") for (int r = 0; r < 16; ++r) o[d][r] *= al_l[crow(r, hi)]; } } while (0)
  s16x4 vA[8], vB[8];
#define VRD8(dst, vb, D0) do { dst[0] = tr_read<v_rd_off(D0, 0, 0)>(vb); dst[1] = tr_read<v_rd_off(D0, 0, 1)>(vb); dst[2] = tr_read<v_rd_off(D0, 1, 0)>(vb); dst[3] = tr_read<v_rd_off(D0, 1, 1)>(vb); \
    dst[4] = tr_read<v_rd_off(D0, 2, 0)>(vb); dst[5] = tr_read<v_rd_off(D0, 2, 1)>(vb); dst[6] = tr_read<v_rd_off(D0, 3, 0)>(vb); dst[7] = tr_read<v_rd_off(D0, 3, 1)>(vb); } while (0)
#define PKV(L, H) (bf16x8){L[0], L[1], L[2], L[3], H[0], H[1], H[2], H[3]}
#define PVM(od, src) do { od = __builtin_amdgcn_mfma_f32_32x32x16_bf16(pa0, PKV(src[0], src[1]), od, 0, 0, 0); od = __builtin_amdgcn_mfma_f32_32x32x16_bf16(pa1, PKV(src[2], src[3]), od, 0, 0, 0); \
    od = __builtin_amdgcn_mfma_f32_32x32x16_bf16(pa2, PKV(src[4], src[5]), od, 0, 0, 0); od = __builtin_amdgcn_mfma_f32_32x32x16_bf16(pa3, PKV(src[6], src[7]), od, 0, 0, 0); } while (0)
#define LW(n) asm volatile("s_waitcnt lgkmcnt(" #n ")" ::: "memory")
#define PVREST(vb) do { SBAR(); VRD8(vB, (vb), 1); LW(8); SBAR(); PVM(o[0], vA); SBAR(); VRD8(vA, (vb), 2); LW(8); SBAR(); PVM(o[1], vB); SBAR(); \
    VRD8(vB, (vb), 3); LW(8); SBAR(); PVM(o[2], vA); SBAR(); LW(0); SBAR(); PVM(o[3], vB); SBAR(); } while (0)
  f32x16 pA0, pA1, pB0, pB1; float mnA, mnB, alA, alB; bf16x8 pa0, pa1, pa2, pa3; constexpr int NT = P::NT;
  SLOAD(0, 0);
  pol.prep(lds);
  asm volatile("s_waitcnt vmcnt(0)" ::: "memory"); SWRITE(0, 0); __syncthreads();
  SLOAD(0, 1);
  qkt<P::ND>(pA0, pA1, K_lds, qr, doff, r32, hi); pol.transform(pA0, pA1, 0); partialSM(pA0, pA1, m_reg, mnA, alA);
  SWRITE(1, 0); __syncthreads();
  for (int j = 1; j + 1 < NT; j += 2) {
    SBAR(); SLOAD(0, j + 1); SBAR();
    qkt<P::ND>(pB0, pB1, (bf16*)((char*)K_lds + SHM_K), qr, doff, r32, hi);
    SBAR(); VRD8(vA, vb0, 0); SBAR();
    finishSM(pA0, pA1, alA, l_reg, pa0, pa1, pa2, pa3);
    PVREST(vb0);
    pol.transform(pB0, pB1, j); partialSM(pB0, pB1, m_reg, mnB, alB);
    __syncthreads(); SWRITE(0, 0);
    RESC(alB); __syncthreads();
    SBAR(); SLOAD(0, j + 2); SBAR();
    qkt<P::ND>(pA0, pA1, K_lds, qr, doff, r32, hi);
    SBAR(); VRD8(vA, vb0 + (int)SHM_V, 0); SBAR();
    finishSM(pB0, pB1, alB, l_reg, pa0, pa1, pa2, pa3);
    PVREST(vb0 + (int)SHM_V);
    pol.transform(pA0, pA1, j + 1); partialSM(pA0, pA1, m_reg, mnA, alA);
    __syncthreads(); SWRITE(1, 0);
    RESC(alA); __syncthreads();
  }
  SBAR(); qkt<P::ND>(pB0, pB1, (bf16*)((char*)K_lds + SHM_K), qr, doff, r32, hi);
  SBAR(); VRD8(vA, vb0, 0); SBAR();
  finishSM(pA0, pA1, alA, l_reg, pa0, pa1, pa2, pa3);
  PVREST(vb0);
  pol.transform(pB0, pB1, NT - 1); partialSM(pB0, pB1, m_reg, mnB, alB);
  RESC(alB);
  SBAR(); VRD8(vA, vb0 + (int)SHM_V, 0); SBAR();
  finishSM(pB0, pB1, alB, l_reg, pa0, pa1, pa2, pa3);
  PVREST(vb0 + (int)SHM_V);
#undef VRD8
#undef PKV
#undef PVM
#undef LW
#undef PVREST
  pol.epilogue(o, m_reg, l_reg, li_l, lds);
#undef SLOAD
#undef SWRITE
#undef RESC
}


#define ATT_STORE_TILE(stg_, VAL, ROWPTR) do { unsigned short* stg__ = (unsigned short*)(stg_); \
    _Pragma("unroll") for (int r = 0; r < 16; ++r) { const int row__ = crow(r, hi); \
      _Pragma("unroll") for (int d = 0; d < 4; ++d) { const float v__ = (VAL); stg__[row__ * 128 + d * 32 + r32] = (unsigned short)(cvtpk(v__, v__) & 0xffffu); } \
      if ((r & 3) == 3) __builtin_amdgcn_sched_barrier(0); } \
    asm volatile("s_waitcnt lgkmcnt(0)" ::: "memory"); \
    const int ln__ = (ltid() & 63); \
    _Pragma("unroll") for (int i = 0; i < 8; ++i) { const int row = 4 * i + (ln__ >> 4); const u32x4 w__ = *(const u32x4*)(stg__ + row * 128 + (ln__ & 15) * 8); \
      *(u32x4*)((ROWPTR) + (ln__ & 15) * 8) = w__; if (i & 1) __builtin_amdgcn_sched_barrier(0); } } while (0)

struct PolA {
  static constexpr int ND = 4, NT = SEQ / KVBLK;
  const bf16* qkv; bf16* obuf; const float* subg; float lam, post;
  int b, h, q0, qg, m, r32, hi; const float* tp0;
  const float* relb_;
  __device__ __forceinline__ void init(const bf16* qkv_, bf16* obuf_, const float* subg_, float lam_, float post_, int b_, int h_, int q0_, const float* relb, char* lds) {
    qkv = qkv_; obuf = obuf_; subg = subg_; lam = lam_; post = post_; b = b_; h = h_; q0 = q0_; relb_ = relb;
    const int tid = ltid(), wid = tid >> 6, lane = tid & 63; qg = wid >> 1; m = wid & 1; r32 = lane & 31; hi = lane >> 5;
    float* tab = (float*)(lds + OFF_TAB);
    const int sq = q0 + 32 * qg + r32;
    tp0 = tab + m * 4096 + (4 * hi - sq + 2047);
  }
  __device__ __forceinline__ void prep(char* lds) const {
    const int tid = ltid(); float* tab = (float*)(lds + OFF_TAB); float* colv = tab + 8192;
    if (tid < 64) colv[tid] = relb_[(tid & 31) * 28 + (tid >> 5) * 8 + h] * LOG2E;
    __syncthreads();
#pragma unroll 4
    for (int i = tid; i < 2 * 4096; i += 512) { const int mm = i >> 12, rel = (i & 4095) - 2047; tab[i] = colv[mm * 32 + rel_bucket(rel)]; }
  }
  __device__ __forceinline__ const bf16* qptr() const { return qkv + QKV_AT(b, q0 + 32 * qg + r32, C_QA + h * 128 + m * 64); }
  __device__ __forceinline__ const bf16* krow(int t, int row) const { return qkv + QKV_AT(b, 64 * t + row, C_KA + h * 128); }
  __device__ __forceinline__ const bf16* vrow(int t, int row) const { return qkv + QKV_AT(b, 64 * t + row, C_VA + h * 128); }
  __device__ __forceinline__ int doff() const { return 4 * m; }
  __device__ __forceinline__ void transform(f32x16& p0, f32x16& p1, int t) const {
    constexpr float C = 0.125f * LOG2E; const float* tp = tp0 + 64 * t;
#pragma unroll
    for (int r = 0; r < 16; ++r) { p0[r] = fmaf(p0[r], C, tp[(r & 3) + 8 * (r >> 2)]); p1[r] = fmaf(p1[r], C, tp[32 + (r & 3) + 8 * (r >> 2)]); }
  }
  __device__ __forceinline__ void epilogue(f32x16* o, float m_reg, float l_reg, float* li_l, char* lds) const {
    if (hi == 0) li_l[r32] = l_reg; asm volatile("s_waitcnt lgkmcnt(0)" ::: "memory");
    const float sc = m ? lam : 1.0f;
#pragma unroll
    for (int r = 0; r < 16; ++r) { const float rl = __builtin_amdgcn_rcpf(li_l[crow(r, hi)]) * sc;
#pragma unroll
      for (int d = 0; d < 4; ++d) o[d][r] *= rl; }
    __syncthreads();
    float* X = (float*)lds; const int lane = ltid() & 63;
    if (m == 1) {
#pragma unroll
      for (int d = 0; d < 4; ++d)
#pragma unroll
        for (int r = 0; r < 16; ++r) X[((qg * 4 + d) * 16 + r) * 64 + lane] = o[d][r];
    }
    __syncthreads();
    if (m == 0) {
      float ss[16];
#pragma unroll
      for (int r = 0; r < 16; ++r) { float s = 0.f;
#pragma unroll
        for (int d = 0; d < 4; ++d) { o[d][r] -= X[((qg * 4 + d) * 16 + r) * 64 + lane]; s += o[d][r] * o[d][r]; }
        ss[r] = s; }
#pragma unroll
      for (int off = 1; off < 32; off <<= 1)
#pragma unroll
        for (int r = 0; r < 16; ++r) ss[r] += __shfl_xor(ss[r], off);
      float gsub[4]; unsigned pbits = __float_as_uint(post); asm volatile("" : "+s"(pbits));
      const float oscale = 1.0f - __uint_as_float(pbits);
#pragma unroll
      for (int d = 0; d < 4; ++d) gsub[d] = subg[d * 32 + r32] * oscale;
      float rn[16];
#pragma unroll
      for (int r = 0; r < 16; ++r) rn[r] = __builtin_amdgcn_rsqf(ss[r] * (1.0f / 128.0f) + EPS);
      ATT_STORE_TILE(lds + OFF_TAB + qg * 8192, o[d][r] * rn[r] * gsub[d], obuf + (size_t)(b * SEQ + q0 + 32 * qg + row) * DM + h * 128);
    }
    __syncthreads();
  }
};

struct PolB {
  static constexpr int ND = 8, NT = 6;
  const bf16* qkv; bf16* ob; float* lse;
  int b, g, hb, P0, l2L, dsh, pq, lo, hi_, r32, hi, wid; const float* tp0;
  __device__ __forceinline__ int tok(int p) const { return ((p & ((1 << l2L) - 1)) << dsh) + (p >> l2L); }
  const float* relb_;
  __device__ __forceinline__ void init(const bf16* qkv_, bf16* ob_, float* lse_, int b_, int g_, int hb_, int P0_, const float* relb, char* lds) {
    qkv = qkv_; ob = ob_; lse = lse_; b = b_; g = g_; hb = hb_; P0 = P0_; dsh = 2 * g; l2L = 11 - dsh; relb_ = relb;
    const int tid = ltid(), lane = tid & 63; wid = tid >> 6; r32 = lane & 31; hi = lane >> 5;
    float* tab = (float*)(lds + OFF_TAB);
    pq = P0 + 32 * wid + r32;
    const int cs = (pq >> l2L) << l2L, ce = cs + (1 << l2L) - 1;
    lo = pq - 64 > cs ? pq - 64 : cs; hi_ = pq + 64 < ce ? pq + 64 : ce;
    tp0 = tab + (P0 - 64 + 4 * hi - pq + 320);
  }
  __device__ __forceinline__ void prep(char* lds) const {
    const int tid = ltid(); float* tab = (float*)(lds + OFF_TAB); float* colv = tab + 8192;
    if (tid < 32) colv[tid] = relb_[tid * 28 + 16 + 4 * g + hb] * LOG2E;
    __syncthreads();
    for (int i = tid; i < 640; i += 512) { const int dp = i - 320; tab[i] = (dp >= -64 && dp <= 64) ? colv[rel_bucket(dp * (1 << dsh))] : 0.f; }
  }
  __device__ __forceinline__ const bf16* qptr() const { return qkv + QKV_AT(b, tok(pq), C_QB + g * 512 + hb * 128); }
  __device__ __forceinline__ const bf16* krow(int t, int row) const { int p = P0 - 64 + 64 * t + row; p = p < 0 ? 0 : (p > SEQ - 1 ? SEQ - 1 : p);
    return qkv + QKV_AT(b, tok(p), C_KB + g * 512 + hb * 128); }
  __device__ __forceinline__ const bf16* vrow(int t, int row) const { int p = P0 - 64 + 64 * t + row; p = p < 0 ? 0 : (p > SEQ - 1 ? SEQ - 1 : p);
    return qkv + QKV_AT(b, tok(p), C_VB + g * 512 + hb * 128); }
  __device__ __forceinline__ int doff() const { return 0; }
  __device__ __forceinline__ void transform(f32x16& p0, f32x16& p1, int t) const {
    constexpr float C = 0.08838834764831845f * LOG2E; const float* tp = tp0 + 64 * t; const int kp0 = P0 - 64 + 64 * t + 4 * hi;
#pragma unroll
    for (int r = 0; r < 16; ++r) { const int c = (r & 3) + 8 * (r >> 2); const int kpa = kp0 + c, kpb = kp0 + 32 + c;
      const float va = fmaf(p0[r], C, tp[c]), vb = fmaf(p1[r], C, tp[32 + c]);
      p0[r] = (kpa >= lo && kpa <= hi_) ? va : -1e30f; p1[r] = (kpb >= lo && kpb <= hi_) ? vb : -1e30f; }
  }
  __device__ __forceinline__ void epilogue(f32x16* o, float m_reg, float l_reg, float* li_l, char* lds) const {
    if (hi == 0) { li_l[r32] = l_reg; lse[(size_t)(b * SEQ + tok(pq)) * 4 + hb] = m_reg + __builtin_amdgcn_logf(l_reg); }
    asm volatile("s_waitcnt lgkmcnt(0)" ::: "memory");
    float rl[16];
#pragma unroll
    for (int r = 0; r < 16; ++r) rl[r] = __builtin_amdgcn_rcpf(li_l[crow(r, hi)]);
    __syncthreads();
    ATT_STORE_TILE(lds + wid * 8192, o[d][r] * rl[r], ob + (size_t)(b * SEQ + tok(P0 + 32 * wid + row)) * 512 + hb * 128);
    __syncthreads();
  }
};

struct PolC {
  static constexpr int ND = 8, NT = MEML / KVBLK;
  const bf16* qkv; const bf16* memkv; bf16* obuf; int b, h, q0, r32, hi, wid;
  __device__ __forceinline__ void init(const bf16* qkv_, const bf16* memkv_, bf16* obuf_, int b_, int h_, int q0_) {
    qkv = qkv_; memkv = memkv_; obuf = obuf_; b = b_; h = h_; q0 = q0_; const int tid = ltid(), lane = tid & 63; wid = tid >> 6; r32 = lane & 31; hi = lane >> 5; }
  __device__ __forceinline__ void prep(char*) const {}
  __device__ __forceinline__ const bf16* qptr() const { return qkv + QKV_AT(b, q0 + 32 * wid + r32, C_QC + h * 128); }
  __device__ __forceinline__ const bf16* krow(int t, int row) const { return memkv + (size_t)(b * MEML + 64 * t + row) * 4096 + h * 128; }
  __device__ __forceinline__ const bf16* vrow(int t, int row) const { return memkv + (size_t)(b * MEML + 64 * t + row) * 4096 + 512 + h * 128; }
  __device__ __forceinline__ int doff() const { return 0; }
  __device__ __forceinline__ void transform(f32x16& p0, f32x16& p1, int) const {
    constexpr float C = 0.08838834764831845f * LOG2E;
#pragma unroll
    for (int r = 0; r < 16; ++r) { p0[r] *= C; p1[r] *= C; }
  }
  __device__ __forceinline__ void epilogue(f32x16* o, float m_reg, float l_reg, float* li_l, char* lds) const {
    if (hi == 0) li_l[r32] = l_reg; asm volatile("s_waitcnt lgkmcnt(0)" ::: "memory");
    float rl[16];
#pragma unroll
    for (int r = 0; r < 16; ++r) rl[r] = __builtin_amdgcn_rcpf(li_l[crow(r, hi)]);
    __syncthreads();
    ATT_STORE_TILE(lds + wid * 8192, o[d][r] * rl[r], obuf + (size_t)(b * SEQ + q0 + 32 * wid + row) * DM + 1536 + h * 128);
    __syncthreads();
  }
};
#undef SBAR
}

constexpr size_t MiB = 1u << 20;
constexpr size_t WS_CTL = 0, CTL_ZERO_BYTES = 2 * MiB;
constexpr size_t WS_X    = 2 * MiB;
constexpr size_t WS_H    = WS_X + 64 * MiB;
constexpr size_t WS_QKV  = WS_H + 32 * MiB;
constexpr size_t WS_HID  = WS_QKV;
constexpr size_t WS_GATE = WS_QKV + 128 * MiB;
constexpr size_t WS_OBUF = WS_GATE + 96 * MiB;
constexpr size_t WS_MRG  = WS_OBUF + 32 * MiB;
constexpr size_t WS_OB3  = WS_MRG + 32 * MiB;
constexpr size_t WS_LSE  = WS_OB3 + 48 * MiB;
constexpr size_t WS_MEMN = WS_LSE + 1 * MiB;
constexpr size_t WS_MEMKV= WS_MEMN + 4 * MiB;
constexpr size_t WS_WMEM = WS_MEMKV + 8 * MiB;
constexpr size_t WS_WIN  = WS_WMEM + 16 * MiB;
constexpr size_t WS_WPRJ = WS_WIN + 56 * MiB;
constexpr size_t WS_WOUT = WS_WPRJ + 8 * MiB;
constexpr size_t WS_WFF  = WS_WOUT + 8 * MiB;
constexpr size_t WS_WDN  = WS_WFF + 44 * MiB;
constexpr size_t WS_END  = WS_WDN + 22 * MiB;
constexpr int CW_BAR = 4096;

constexpr int RING_BYTES = 131072, LDSCTL_OFF = RING_BYTES, MISC_OFF = LDSCTL_OFF + 320, LDS_BYTES = 147456;
constexpr int NWAVES = 8;

#define LDS_WAIT() asm volatile("s_waitcnt lgkmcnt(0)" ::: "memory")
#define VM_WAIT() asm volatile("s_waitcnt vmcnt(0)" ::: "memory")

#define XB_TMO      128
#define XB_XCNT(j)  (256  + 64 * (j))
#define XB_XSUB(j)  (1280 + 64 * (j))
#define XB_XGEN(j)  (2304 + 64 * (j))
#define XB_TOP      3328
#define XB_TOPGEN   3392
#define XCD_BAR_WORDS 3456
#define XB_SPIN_CAP (1u << 18)
__device__ __forceinline__ unsigned xb_ld(unsigned* p)              { return __hip_atomic_load(p, __ATOMIC_RELAXED, __HIP_MEMORY_SCOPE_AGENT); }
__device__ __forceinline__ unsigned xb_add(unsigned* p, unsigned v) { return __hip_atomic_fetch_add(p, v, __ATOMIC_RELAXED, __HIP_MEMORY_SCOPE_AGENT); }
__device__ __forceinline__ unsigned xb_xcc_id() { return (unsigned)__builtin_amdgcn_s_getreg((3 << 11) | 20) & 0xFu; }
#define XB_SPIN(cond, bar) do { unsigned _sp = 0; while (cond) { __builtin_amdgcn_s_sleep(1); \
    if ((++_sp & 255u) == 0u) { if (xb_ld(&(bar)[XB_TMO])) break; if (_sp > XB_SPIN_CAP) { atomicAdd(&(bar)[XB_TMO], 1u); break; } } } } while (0)
struct XcdBarrier { unsigned* bar; unsigned x; volatile LAS unsigned* st; };
__device__ __forceinline__ XcdBarrier xcd_barrier_post(unsigned* bar, volatile LAS unsigned* st) {
    XcdBarrier b; b.bar = bar; b.x = xb_xcc_id(); b.st = st;
    if (threadIdx.x == 0) (void)xb_add(&bar[XB_XCNT(b.x)], 1u);
    return b;
}
__device__ __forceinline__ void xcd_barrier_complete(unsigned* bar, unsigned x, unsigned& nloc, unsigned& nx) {
    const unsigned G = gridDim.x * gridDim.y * gridDim.z;
    unsigned sum, cnt, mine, sp = 0u;
    for (;;) {
        sum = 0u; cnt = 0u; mine = 0u;
#pragma unroll
        for (unsigned j = 0; j < 16; ++j) { const unsigned c = xb_ld(&bar[XB_XCNT(j)]); sum += c; cnt += (c > 0u) ? 1u : 0u; mine = (j == x) ? c : mine; }
        if (sum == G) break;
        __builtin_amdgcn_s_sleep(1);
        if ((++sp & 255u) == 0u) { if (xb_ld(&bar[XB_TMO])) break; if (sp > XB_SPIN_CAP) { atomicAdd(&bar[XB_TMO], 1u); break; } }
    }
    nloc = mine > 0u ? mine : 1u; nx = cnt > 0u ? cnt : 1u;
}
__device__ __forceinline__ void xcd_barrier(const XcdBarrier& b) {
    asm volatile("s_waitcnt vmcnt(0)" ::: "memory");
    __syncthreads();
    if (threadIdx.x == 0) {
        unsigned* bar = b.bar;
        __builtin_amdgcn_s_waitcnt(0);
        unsigned nloc = b.st[0], nx = b.st[1];
        if (nloc == 0u) { xcd_barrier_complete(bar, b.x, nloc, nx); b.st[0] = nloc; b.st[1] = nx; }
        const unsigned old = xb_add(&bar[XB_XSUB(b.x)], 1u);
        const unsigned gen = old / nloc;
        if (old + 1u == (gen + 1u) * nloc) {
            __builtin_amdgcn_fence(__ATOMIC_RELEASE, "agent");
            asm volatile("s_waitcnt vmcnt(0)" ::: "memory");
            const unsigned og = xb_add(&bar[XB_TOP], 1u);
            const unsigned tg = og / nx;
            if (og + 1u == (tg + 1u) * nx) xb_add(&bar[XB_TOPGEN], 1u);
            else XB_SPIN(xb_ld(&bar[XB_TOPGEN]) == tg, bar);
            __builtin_amdgcn_fence(__ATOMIC_ACQUIRE, "agent");
            xb_add(&bar[XB_XGEN(b.x)], 1u);
            asm volatile("s_waitcnt vmcnt(0)" ::: "memory");
        } else {
            XB_SPIN(xb_ld(&bar[XB_XGEN(b.x)]) == gen, bar);
            __builtin_amdgcn_fence(__ATOMIC_ACQUIRE, "agent");
            asm volatile("s_waitcnt vmcnt(0)" ::: "memory");
        }
    }
    __syncthreads();
}

__device__ __forceinline__ float wave_sum(float v) {
#pragma unroll
    for (int o = 1; o < 64; o <<= 1) v += __shfl_xor(v, o);
    return v;
}
__device__ __forceinline__ unsigned pkbf(float lo, float hi) { return pg8::cvt_pk_bf16(lo, hi); }

__device__ __forceinline__ void rms_row_bf16(const float* xrow, const float* gain, bf16* orow, int lane) {
    const f32x4* xr = (const f32x4*)xrow + lane; const f32x4* gr = (const f32x4*)gain + lane;
    f32x4 v[8]; float s = 0.f;
#pragma unroll
    for (int j = 0; j < 8; ++j) { v[j] = xr[64 * j]; s += (v[j].x * v[j].x + v[j].y * v[j].y) + (v[j].z * v[j].z + v[j].w * v[j].w); }
    const float rstd = 1.0f / sqrtf(wave_sum(s) * (1.f / DM) + EPS);
    v2u* o8 = (v2u*)orow + lane;
#pragma unroll
    for (int j = 0; j < 8; ++j) { const f32x4 g = gr[64 * j]; v2u w; w.x = pkbf(v[j].x * rstd * g.x, v[j].y * rstd * g.y); w.y = pkbf(v[j].z * rstd * g.z, v[j].w * rstd * g.w); o8[64 * j] = w; }
}
__device__ __forceinline__ void rms_row_f32(const float* xrow, const float* gain, float* orow, int lane) {
    const f32x4* xr = (const f32x4*)xrow + lane; const f32x4* gr = (const f32x4*)gain + lane;
    f32x4 v[8]; float s = 0.f;
#pragma unroll
    for (int j = 0; j < 8; ++j) { v[j] = xr[64 * j]; s += (v[j].x * v[j].x + v[j].y * v[j].y) + (v[j].z * v[j].z + v[j].w * v[j].w); }
    const float rstd = 1.0f / sqrtf(wave_sum(s) * (1.f / DM) + EPS);
    f32x4* o = (f32x4*)orow + lane;
#pragma unroll
    for (int j = 0; j < 8; ++j) { const f32x4 g = gr[64 * j]; o[64 * j] = v[j] * rstd * g; }
}

struct WtDesc { const float* W; const float* gn; bf16* dst; int N, ldk; };
__device__ __forceinline__ void wt_load(f32x4 (&v)[16], float (&gv)[16], const WtDesc& D, int lane) {
    const float* src = D.W + (size_t)(16 * (lane >> 4)) * D.N + 4 * (lane & 15);
#pragma unroll
    for (int i = 0; i < 16; ++i) v[i] = __builtin_nontemporal_load((const f32x4*)(src + (size_t)i * D.N));
    if (D.gn) { const f32x4* g4 = (const f32x4*)(D.gn + 16 * (lane >> 4));
#pragma unroll
        for (int i = 0; i < 4; ++i) { const f32x4 g = g4[i]; gv[4 * i] = g.x; gv[4 * i + 1] = g.y; gv[4 * i + 2] = g.z; gv[4 * i + 3] = g.w; } }
    else {
#pragma unroll
        for (int i = 0; i < 16; ++i) gv[i] = 1.0f; }
}
__device__ __forceinline__ void wt_proc_a(const f32x4 (&v)[16], const float (&gv)[16], LAS unsigned char* T, int lane) {
    LAS unsigned char* tw = T + (4 * (lane & 15)) * 144 + (16 * (lane >> 4)) * 2;
#pragma unroll
    for (int i4 = 0; i4 < 4; ++i4) { const f32x4 a = v[4 * i4] * gv[4 * i4], b = v[4 * i4 + 1] * gv[4 * i4 + 1], c = v[4 * i4 + 2] * gv[4 * i4 + 2], d = v[4 * i4 + 3] * gv[4 * i4 + 3];
#pragma unroll
        for (int cc = 0; cc < 4; ++cc) { v2u w; w.x = pkbf(a[cc], b[cc]); w.y = pkbf(c[cc], d[cc]); *(LAS v2u*)(tw + cc * 144 + i4 * 8) = w; } }
    LDS_WAIT(); asm volatile("" ::: "memory");
}
__device__ __forceinline__ void wt_proc_b(const WtDesc& D, LAS unsigned char* T, int lane) {
    const LAS unsigned char* tr = T + (lane >> 3) * 144 + (lane & 7) * 16;
    bf16* dst = D.dst + (size_t)(lane >> 3) * D.ldk + (lane & 7) * 8;
    v4u w[8];
#pragma unroll
    for (int r = 0; r < 8; ++r) w[r] = *(const LAS v4u*)(tr + r * 8 * 144);
#pragma unroll
    for (int r = 0; r < 8; ++r) __builtin_nontemporal_store(w[r], (v4u*)(dst + (size_t)(8 * r) * D.ldk));
    LDS_WAIT(); asm volatile("" ::: "memory");
}
__device__ __forceinline__ void wt_proc(const f32x4 (&v)[16], const float (&gv)[16], const WtDesc& D, LAS unsigned char* T, int lane) { wt_proc_a(v, gv, T, lane); wt_proc_b(D, T, lane); }
__device__ __forceinline__ void wt_item(const float* W, int N, int k0, int n0, bf16* wt0, int ldk, LAS unsigned char* T, int lane, const float* gain = nullptr) {
    WtDesc D; D.W = W + (size_t)k0 * N + n0; D.gn = gain ? gain + k0 : nullptr; D.dst = wt0; D.N = N; D.ldk = ldk;
    f32x4 v[16]; float gv[16]; wt_load(v, gv, D, lane); wt_proc(v, gv, D, T, lane);
}
constexpr int IT_WIN = (DM / 64) * (NIN / 64), IT_WGATE = (DM / 64) * (NGATE / 64), IT_PA = (1024 / 64) * (DM / 64), IT_PB = (512 / 64) * (DM / 64), IT_PC = IT_PB,
              IT_WOUT = (DM / 64) * (DM / 64), IT_FG = (DM / 64) * (DFF / 64), IT_FU = IT_FG, IT_FD = (DFF / 64) * (DM / 64);
constexpr int IT_E0 = IT_WIN, IT_E1 = IT_E0 + IT_WGATE, IT_E2 = IT_E1 + IT_PA, IT_E3 = IT_E2 + IT_PB, IT_E4 = IT_E3 + IT_PC, IT_E5 = IT_E4 + IT_WOUT, IT_E6 = IT_E5 + IT_FG, IT_E7 = IT_E6 + IT_FU, IT_E8 = IT_E7 + IT_FD;
struct Args {
    const float* in[20]; float* out; unsigned char* ws; int ph_lo, ph_hi, li, pad;
};
constexpr int PH_PRO = 0, PH_MEMKV = 1, PH_L0 = 2, PH_PER_LAYER = 7, PH_FINAL = PH_L0 + DEPTH * PH_PER_LAYER, PH_N = PH_FINAL + 1;
constexpr int CW_QUEUE = 150000;
constexpr int CW_SS = 262144;
static_assert((size_t)CW_SS * 4 + (size_t)9 * MTOK * 8 <= CTL_ZERO_BYTES && CW_BAR + 40 * XCD_BAR_WORDS <= CW_QUEUE, "CTL map");

#define CONV_DECODE(D_, it_, lw_) do { const int ci_ = (it_); const int clw_ = (lw_); \
        const float* W; int K, N, ldk, koff, r, swz; bf16* WT; int rowoff; const float* gn = nullptr; \
        if (ci_ < IT_E0)      { r = ci_;         W = INP(5) + (size_t)clw_ * DM * NIN;    K = DM;   N = NIN;   WT = P_WIN;  ldk = DM;  koff = 0;    rowoff = 0;   swz = -1; gn = INP(4) + clw_ * DM; } \
        else if (ci_ < IT_E1) { r = ci_ - IT_E0; W = INP(9) + (size_t)clw_ * DM * NGATE;  K = DM;   N = NGATE; WT = P_WIN;  ldk = DM;  koff = 0;    rowoff = NIN; swz = -1; gn = INP(4) + clw_ * DM; } \
        else if (ci_ < IT_E2) { r = ci_ - IT_E1; W = INP(11) + (size_t)clw_ * 1024 * DM;  K = 1024; N = DM;    WT = P_WPRJ; ldk = DM;  koff = 0;    rowoff = 0;   swz = -1; } \
        else if (ci_ < IT_E3) { r = ci_ - IT_E2; W = INP(12) + (size_t)clw_ * 512 * DM;   K = 512;  N = DM;    WT = P_WPRJ; ldk = DM;  koff = 1024; rowoff = 0;   swz = -1; } \
        else if (ci_ < IT_E4) { r = ci_ - IT_E3; W = INP(13) + (size_t)clw_ * 512 * DM;   K = 512;  N = DM;    WT = P_WPRJ; ldk = DM;  koff = 1536; rowoff = 0;   swz = -1; } \
        else if (ci_ < IT_E5) { r = ci_ - IT_E4; W = INP(14) + (size_t)clw_ * DM * DM;    K = DM;   N = DM;    WT = P_WOUT; ldk = DM;  koff = 0;    rowoff = 0;   swz = -1; } \
        else if (ci_ < IT_E6) { r = ci_ - IT_E5; W = INP(16) + (size_t)clw_ * DM * DFF;   K = DM;   N = DFF;   WT = P_WFF;  ldk = DM;  koff = 0;    rowoff = 0;   swz = 0; gn = INP(15) + clw_ * DM; } \
        else if (ci_ < IT_E7) { r = ci_ - IT_E6; W = INP(17) + (size_t)clw_ * DM * DFF;   K = DM;   N = DFF;   WT = P_WFF;  ldk = DM;  koff = 0;    rowoff = 0;   swz = 1; gn = INP(15) + clw_ * DM; } \
        else                 { r = ci_ - IT_E7; W = INP(18) + (size_t)clw_ * DFF * DM;   K = DFF;  N = DM;    WT = P_WDN;  ldk = DFF; koff = 0;    rowoff = 0;   swz = -1; } \
        const int nnb = N >> 6, kb = r / nnb, nb = r - kb * nnb, n0 = nb * 64, k0 = kb * 64;     \
        const int drow = swz < 0 ? (rowoff + n0) : ((n0 >> 7) * 256 + swz * 128 + (n0 & 127)); \
        (D_).W = W + (size_t)k0 * N + n0; (D_).gn = gn ? gn + k0 : nullptr; (D_).dst = WT + (size_t)drow * ldk + koff + k0; (D_).N = N; (D_).ldk = ldk; } while (0)
#define CONV_ITEM(it_, lw_) do { WtDesc D_; CONV_DECODE(D_, it_, lw_); f32x4 v_[16]; float g_[16]; wt_load(v_, g_, D_, lane); wt_proc(v_, g_, D_, Twave, lane); } while (0)

__global__ void __launch_bounds__(NWAVES * 64, 2) trunk_fwd(Args args) {
    extern __shared__ __attribute__((aligned(16))) unsigned char lds[];
    LAS unsigned char* ldsl = (LAS unsigned char*)lds;
    volatile LAS unsigned* MISC = (volatile LAS unsigned*)(ldsl + MISC_OFF);
    const int tid = threadIdx.x, wave = __builtin_amdgcn_readfirstlane(tid >> 6);
#define LANE() (att::ltid() & 63)
    const int G = gridDim.x; const int bx = blockIdx.x; const int vcu = (G % 8 == 0) ? (bx % 8) * (G / 8) + bx / 8 : bx;
    const int gw = vcu * NWAVES + wave, NGW = G * NWAVES;
    typedef const __attribute__((address_space(4))) Args* KArgs;
    unsigned long long ka_bits = (unsigned long long)__builtin_amdgcn_kernarg_segment_ptr();
#define KA() ({ asm volatile("" : "+s"(ka_bits)); (KArgs)ka_bits; })
#define WSP(off) ((unsigned char*)KA()->ws + (off))
#define INP(k) (KA()->in[k])
    unsigned* ctl = (unsigned*)WSP(WS_CTL);
    for (int u = tid; u < (LDS_BYTES - LDSCTL_OFF) / 4; u += NWAVES * 64) ((LAS unsigned*)(ldsl + LDSCTL_OFF))[u] = 0u;
    __syncthreads();
    XcdBarrier bar = xcd_barrier_post(ctl + CW_BAR + KA()->li * XCD_BAR_WORDS, MISC + 8);
    const int lo = KA()->ph_lo, hi = KA()->ph_hi;
#define IN(k) (lo <= (k) && (k) < hi)
#define SEAM(k) do { if (IN(k) && IN((k) + 1)) xcd_barrier(bar); } while (0)

#define P_X      ((float*)WSP(WS_X))
#define P_XB     ((bf16*)WSP(WS_H))
#define P_QKV    ((bf16*)WSP(WS_QKV))
#define P_HID    ((bf16*)WSP(WS_HID))
#define P_GATE   ((bf16*)WSP(WS_GATE))
#define P_OBUF   ((bf16*)WSP(WS_OBUF))
#define P_MRG    ((bf16*)WSP(WS_MRG))
#define P_OB3    ((bf16*)WSP(WS_OB3))
#define P_LSE    ((float*)WSP(WS_LSE))
#define P_MEMN   ((bf16*)WSP(WS_MEMN))
#define P_MEMKV  ((bf16*)WSP(WS_MEMKV))
#define P_WMEM   ((bf16*)WSP(WS_WMEM))
#define P_WIN    ((bf16*)WSP(WS_WIN))
#define P_WPRJ   ((bf16*)WSP(WS_WPRJ))
#define P_WOUT   ((bf16*)WSP(WS_WOUT))
#define P_WFF    ((bf16*)WSP(WS_WFF))
#define P_WDN    ((bf16*)WSP(WS_WDN))
#define P_SS(i)  ((unsigned long long*)((unsigned*)WSP(WS_CTL) + CW_SS) + (i) * MTOK)
    LAS unsigned char* Twave = ldsl + wave * 9216;

    if (IN(PH_PRO)) {
        const int lane = LANE();
        { const float* w_mem_kv = INP(8); bf16* WMEM = P_WMEM;
          for (int it = gw; it < DEPTH * (DM / 64) * (1024 / 64); it += NGW) { const int l = it >> 9, r = it & 511, kb = r >> 4, nb = r & 15;
              wt_item(w_mem_kv + (size_t)l * DM * 1024, 1024, kb * 64, nb * 64, WMEM + (size_t)(l * 1024 + nb * 64) * DM + kb * 64, DM, Twave, lane); } }
        { const float* mem = INP(1); const float* mem_norm = INP(3); bf16* MEMN = P_MEMN;
          for (int m = gw; m < NB * MEML; m += NGW) rms_row_bf16(mem + (size_t)m * DM, mem_norm, MEMN + (size_t)m * DM, lane); }
    }
    SEAM(PH_PRO);
    if (IN(PH_MEMKV)) {
        constexpr int NMU = (NB * MEML / 256) * (4096 / 256);
        { pg8::Gemm g{P_MEMN, P_WMEM, NB * MEML, 4096, DM}; pg8::StaticOrder S; S.init(NB * MEML, 4096, G, bx);
            pg8::EpiPlain E{P_MEMKV, 4096};
            pg8::gemm_phase<pg8::EpiPlain, pg8::StaticOrder, true, true>(ldsl, g, S, E); }
        const bool split = G > 2 * NMU;
        if (!split || bx >= NMU) {
            const int lane = LANE();
            const int tgw = split ? (bx - NMU) * NWAVES + wave : bx * NWAVES + wave, tngw = split ? (G - NMU) * NWAVES : G * NWAVES;
            for (int it = tgw; it < IT_E1; it += tngw) CONV_ITEM(it, 0);
            { const float* xin = INP(0); bf16* XB = P_XB; unsigned long long* ss0 = P_SS(0);
              for (int m = tgw; m < MTOK; m += tngw) { const f32x4* xr = (const f32x4*)(xin + (size_t)m * DM) + lane; v2u* o8 = (v2u*)(XB + (size_t)m * DM) + lane; float sq = 0.f;
#pragma unroll
                  for (int j = 0; j < 8; ++j) { const f32x4 v = xr[64 * j]; v2u w; w.x = pkbf(v.x, v.y); w.y = pkbf(v.z, v.w); o8[64 * j] = w;
                      const float r0 = pg8::bf_lo(w.x), r1 = pg8::bf_hi(w.x), r2 = pg8::bf_lo(w.y), r3 = pg8::bf_hi(w.y); sq += (r0 * r0 + r1 * r1) + (r2 * r2 + r3 * r3); }
                  sq = wave_sum(sq); if (lane == 0) ss0[m] = (unsigned long long)(sq * 1048576.0f + 0.5f); } }
        }
    }
    SEAM(PH_MEMKV);

    for (int l = 0; l < DEPTH; ++l) {
        const int pb = PH_L0 + l * PH_PER_LAYER;
        if (IN(pb + 0)) {
            pg8::Gemm g{P_XB, P_WIN, MTOK, NIN + NGATE, DM}; pg8::StaticOrder S; S.init(MTOK, NIN + NGATE, G, bx);
            pg8::EpiInGate E{P_QKV, P_GATE, INP(10) + (size_t)l * NGATE, P_SS(2 * l)};
            pg8::gemm_phase<pg8::EpiInGate, pg8::StaticOrder, true, true>(ldsl, g, S, E);
        }
        SEAM(pb + 0);
        if (IN(pb + 1)) {
            float lam, post;
            { const int lane = LANE(); const float* dl = INP(6) + (size_t)l * 256; const float s1 = wave_sum(dl[lane] * dl[64 + lane]), s2 = wave_sum(dl[128 + lane] * dl[192 + lane]);
              const float lam_init = 0.8f - 0.6f * expf(-0.3f * (float)l); const float lamv = expf(s1) - expf(s2) + lam_init;
              lam = __uint_as_float(__builtin_amdgcn_readfirstlane(__float_as_uint(lamv))); post = __uint_as_float(__builtin_amdgcn_readfirstlane(__float_as_uint(lam_init))); }
            constexpr int NCH = 85, IPC = 208, NLOC = IT_E8 - IT_E1;
            static_assert(NCH * IPC >= IT_E8, "conversion chunks cover every item");
            const int TI = NLOC + (l + 1 < DEPTH ? IT_E1 : 0);
            const int qx = bx & 7, ncx = (NCH - qx + 7) >> 3, QR = 64 + ncx;
            unsigned* qhead = ctl + CW_QUEUE + 64 * (l * 8 + qx);
            for (;;) {
                __syncthreads();
                if (tid == 0) MISC[16] = __hip_atomic_fetch_add(qhead, 1u, __ATOMIC_RELAXED, __HIP_MEMORY_SCOPE_AGENT);
                __syncthreads();
                const int u = __builtin_amdgcn_readfirstlane((int)MISC[16]);
                if (u >= QR + 64) break;
                if (u < QR) {
                    if ((u & 3) == 0 && (u >> 2) < ncx) {
                        const int c = qx + 8 * (u >> 2); const int lane = LANE();
                        int j = c * IPC + wave; const int jend = (c + 1) * IPC < TI ? (c + 1) * IPC : TI;
#define JDEC(D, jj) do { const int jj_ = (jj); if (jj_ < NLOC) CONV_DECODE(D, IT_E1 + jj_, l); else CONV_DECODE(D, jj_ - NLOC, l + 1); } while (0)
                        if (j < jend) {
                            WtDesc D; f32x4 v[16]; float gv[16];
                            JDEC(D, j); wt_load(v, gv, D, lane);
                            for (;;) {
                                const int j1 = j + 8; const bool h1 = j1 < jend;
                                WtDesc Dn; if (h1) JDEC(Dn, j1);
                                wt_proc_a(v, gv, Twave, lane);
                                if (h1) wt_load(v, gv, Dn, lane);
                                wt_proc_b(D, Twave, lane);
                                if (!h1) break;
                                D = Dn; j = j1;
                            }
                        }
#undef JDEC
                        LDS_WAIT();
                    } else {
                        const int cb = (u >> 2) + 1, al = u - (cb < ncx ? cb : ncx), au = (qx * 4 + (al >> 4)) * 16 + (al & 15);
                        const int chunk = au & 15, h = (au >> 4) & 7, b = au >> 7;
                        att::PolA P; P.init(P_QKV, P_OBUF, INP(7) + l * 128, lam, post, b, h, chunk * 128, INP(2), (char*)lds);
                        att::attn_unit<att::PolA>(P, (char*)lds);
                    }
                } else if (u < QR + 48) { {
                    const int su = qx * 48 + (u - QR); const int g_ = su % 3, r = su / 3, chunk = r & 7, hb = (r >> 3) & 3, b = r >> 5;
                    att::PolB P; P.init(P_QKV, P_OB3 + (size_t)g_ * MTOK * 512, P_LSE + (size_t)g_ * MTOK * 4, b, g_, hb, chunk * 256, INP(2), (char*)lds);
                    att::attn_unit<att::PolB>(P, (char*)lds); }
                } else { {
                    const int r = qx * 16 + (u - QR - 48), chunk = r & 7, h = (r >> 3) & 3, b = r >> 5;
                    att::PolC P; P.init(P_QKV, P_MEMKV + l * 1024, P_OBUF, b, h, chunk * 256);
                    att::attn_unit<att::PolC>(P, (char*)lds); }
                }
            }
        }
        SEAM(pb + 1);
        if (IN(pb + 2)) {
            const int lane = LANE();
            const float* LSE = P_LSE; const bf16* OB3 = P_OB3; bf16* OBUF = P_OBUF;
            for (int m = gw; m < MTOK; m += NGW) {
                const int hb = lane >> 4;
                const float l0 = LSE[(size_t)m * 4 + hb], l1 = LSE[(size_t)(MTOK + m) * 4 + hb], l2 = LSE[(size_t)(2 * MTOK + m) * 4 + hb];
                const float mx = fmaxf(l0, fmaxf(l1, l2));
                float a0 = __builtin_amdgcn_exp2f(l0 - mx), a1 = __builtin_amdgcn_exp2f(l1 - mx), a2 = __builtin_amdgcn_exp2f(l2 - mx);
                const float inv = 1.0f / (a0 + a1 + a2); a0 *= inv; a1 *= inv; a2 *= inv;
                const bf16* p0 = OB3 + (size_t)m * 512 + lane * 8;
                const v4u u = *(const v4u*)p0, v = *(const v4u*)(p0 + (size_t)MTOK * 512), w3 = *(const v4u*)(p0 + (size_t)2 * MTOK * 512);
#define CMB(x_) (pg8::bf_lo(u.x_) * a0 + pg8::bf_lo(v.x_) * a1 + pg8::bf_lo(w3.x_) * a2), (pg8::bf_hi(u.x_) * a0 + pg8::bf_hi(v.x_) * a1 + pg8::bf_hi(w3.x_) * a2)
                v4u w; w.x = pkbf(CMB(x)); w.y = pkbf(CMB(y)); w.z = pkbf(CMB(z)); w.w = pkbf(CMB(w));
#undef CMB
                *(v4u*)(OBUF + (size_t)m * DM + 1024 + lane * 8) = w;
            }
        }
        SEAM(pb + 2);
        if (IN(pb + 3)) {
            pg8::Gemm g{P_OBUF, P_WPRJ, MTOK, DM, DM}; pg8::StaticOrder S; S.init(MTOK, DM, G, bx);
            pg8::EpiProj E{P_GATE, P_MRG};
            pg8::gemm_phase<pg8::EpiProj, pg8::StaticOrder, true, true>(ldsl, g, S, E);
        }
        SEAM(pb + 3);
        if (IN(pb + 4)) {
            pg8::Gemm g{P_MRG, P_WOUT, MTOK, DM, DM}; pg8::StaticOrder S; S.init(MTOK, DM, G, bx);
            pg8::EpiResid E{(l == 0) ? INP(0) : (const float*)nullptr, P_XB, P_SS(2 * l + 1)};
            pg8::gemm_phase<pg8::EpiResid, pg8::StaticOrder, true, true>(ldsl, g, S, E);
        }
        SEAM(pb + 4);
        if (IN(pb + 5)) {
            pg8::Gemm g{P_XB, P_WFF, MTOK, 2 * DFF, DM}; pg8::StaticOrder S; S.init(MTOK, 2 * DFF, G, bx);
            pg8::EpiSwiGLU E{P_HID, P_SS(2 * l + 1)};
            pg8::gemm_phase<pg8::EpiSwiGLU, pg8::StaticOrder, true, true>(ldsl, g, S, E);
        }
        SEAM(pb + 5);
        if (IN(pb + 6)) {
            pg8::Gemm g{P_HID, P_WDN, MTOK, DM, DFF}; pg8::StaticOrder S; S.init(MTOK, DM, G, bx);
            pg8::EpiResid E{nullptr, P_XB, P_SS(2 * l + 2)};
            pg8::gemm_phase<pg8::EpiResid, pg8::StaticOrder, true, true>(ldsl, g, S, E);
        }
        SEAM(pb + 6);
    }
    if (IN(PH_FINAL)) {
        const int lane = LANE();
        const bf16* Xp = P_XB; const float* gn = INP(19); float* outp = KA()->out; const unsigned long long* ss = P_SS(8);
        for (int m = gw; m < MTOK; m += NGW) { const float rstd = 1.0f / sqrtf((float)ss[m] * (1.f / (DM * 1048576.0f)) + EPS);
            const v2u* xr = (const v2u*)(Xp + (size_t)m * DM) + lane; const f32x4* gr = (const f32x4*)gn + lane; f32x4* o = (f32x4*)(outp + (size_t)m * DM) + lane;
#pragma unroll
            for (int j = 0; j < 8; ++j) { const v2u p = xr[64 * j]; const f32x4 x = (f32x4){pg8::bf_lo(p.x), pg8::bf_hi(p.x), pg8::bf_lo(p.y), pg8::bf_hi(p.y)}; o[64 * j] = x * rstd * gr[64 * j]; } }
    }
#undef IN
#undef SEAM
}

extern "C" void kernel_launch(void* const* d_in, const int* in_sizes, int n_in, void* d_out, int out_size, void* d_ws, size_t ws_size, hipStream_t stream) {
    static int grid = 0;
    if (grid == 0) {
        if (n_in != 20 || out_size != MTOK * DM || ws_size < WS_END) { fprintf(stderr, "kernel_launch: unexpected shapes: n_in %d out %d ws %zu (need %zu)\n", n_in, out_size, ws_size, (size_t)WS_END); grid = -1; return; }
        int dev = 0, cus = 0, per_cu = 0;
        if (hipGetDevice(&dev) != hipSuccess || hipDeviceGetAttribute(&cus, hipDeviceAttributeMultiprocessorCount, dev) != hipSuccess) { grid = -1; return; }
        if (hipFuncSetAttribute((const void*)trunk_fwd, hipFuncAttributeMaxDynamicSharedMemorySize, LDS_BYTES) != hipSuccess) { fprintf(stderr, "kernel_launch: hipFuncSetAttribute failed\n"); grid = -1; return; }
        if (hipOccupancyMaxActiveBlocksPerMultiprocessor(&per_cu, (const void*)trunk_fwd, NWAVES * 64, LDS_BYTES) != hipSuccess || per_cu < 1)
            fprintf(stderr, "kernel_launch: occupancy query reports %d workgroups per CU\n", per_cu);
        (void)hipGetLastError();
        grid = cus;
    }
    if (grid < 0) return;
    if (hipMemsetAsync((char*)d_ws + WS_CTL, 0, CTL_ZERO_BYTES, stream) != hipSuccess) { fprintf(stderr, "kernel_launch: memset failed\n"); return; }
    Args a{};
    for (int i = 0; i < 20; ++i) a.in[i] = (const float*)d_in[i];
    a.out = (float*)d_out; a.ws = (unsigned char*)d_ws; a.pad = 0;
#if MK_PER_PHASE
    for (int p = 0; p < PH_N; ++p) { a.ph_lo = p; a.ph_hi = p + 1; a.li = p;
        hipLaunchKernelGGL(trunk_fwd, dim3(grid), dim3(NWAVES * 64), LDS_BYTES, stream, a); }
#else
    a.ph_lo = 0; a.ph_hi = PH_N; a.li = 0;
    hipLaunchKernelGGL(trunk_fwd, dim3(grid), dim3(NWAVES * 64), LDS_BYTES, stream, a);
#endif
    const hipError_t le = hipPeekAtLastError();
    if (le != hipSuccess) fprintf(stderr, "kernel_launch: launch failed: %s\n", hipGetErrorName(le));
}
```

```cpp
#include <hip/hip_runtime.h>
#include <cstdio>
#include <cstdint>


#ifndef MK_PER_PHASE
#define MK_PER_PHASE 0
#endif

namespace pg8 {
#define PG8_LAS __attribute__((address_space(3)))
typedef unsigned short bf16_t;
typedef short bf16x8 __attribute__((ext_vector_type(8)));
typedef float f32x4 __attribute__((ext_vector_type(4)));
typedef unsigned u32x4 __attribute__((ext_vector_type(4)));
constexpr int BM = 256, BK = 64, HALF = 128, HTB = HALF * BK * 2, STAGE_BYTES = 8 * HTB, NXCD = 8, WGM = 8;

__host__ __device__ __forceinline__ int lds_byte(int r, int c) { const int st = (r >> 4) * 2 + (c >> 5), rr = r & 15, cc = c & 31, ob = rr * 64 + cc * 2; return st * 1024 + (ob ^ (((ob >> 9) & 1) << 5)); }
__host__ __device__ __forceinline__ void stage_rc(int b, int& R, int& C) { const int st = b / 1024, sb = b % 1024, swz = sb ^ (((sb >> 9) & 1) << 5); R = (st >> 1) * 16 + swz / 64; C = (st & 1) * 32 + (swz % 64) / 2; }
__host__ __device__ __forceinline__ int perm32(int rho) { const int n = rho >> 4, i = rho & 15; return 8 * (i >> 2) + 4 * n + (i & 3); }

struct Unit { int pm, pn; };
struct Gemm { const bf16_t* A; const bf16_t* Bt; int M, N, K; };

struct StaticOrder {
    int nM, nN, nwg, G, c;
    __host__ __device__ void init(int M, int N, int G_, int c_) { nM = M / BM; nN = N / BM; nwg = nM * nN; G = G_; c = c_; }
    __host__ __device__ bool next(int i, Unit& u) const {
        const long L = (long)i * G + c; if (L >= nwg) return false;
        int wgid = (int)L; { const int q = nwg / NXCD, r = nwg % NXCD, xcd = wgid % NXCD, off = wgid / NXCD; wgid = (xcd < r ? xcd * (q + 1) : r * (q + 1) + (xcd - r) * q) + off; }
        const int nig = WGM * nN, gid = wgid / nig, fm = gid * WGM, gsz = (nM - fm) < WGM ? (nM - fm) : WGM;
        u.pm = fm + ((wgid % nig) % gsz); u.pn = (wgid % nig) / gsz; return true;
    }
    __device__ __forceinline__ void a_ready(const Unit&) const {}
    __device__ __forceinline__ void done(const Unit&) const {}
};

__device__ __forceinline__ unsigned cvt_pk_bf16(float lo, float hi) { unsigned r; asm volatile("v_cvt_pk_bf16_f32 %0, %1, %2" : "=v"(r) : "v"(lo), "v"(hi)); return r; }
__device__ __forceinline__ float bf_lo(unsigned w) { return __uint_as_float(w << 16); }
__device__ __forceinline__ float bf_hi(unsigned w) { return __uint_as_float(w & 0xffff0000u); }
__device__ __forceinline__ float sigmoidf_(float v) { return __builtin_amdgcn_rcpf(1.0f + __builtin_amdgcn_exp2f(-1.4426950408889634f * v)); }


struct EpiInGate {
    static constexpr bool PERM = true, AFTER_DRAIN = false, HAS_MID = false;
    bf16_t* qkv; bf16_t* gate; const float* bgate; const unsigned long long* ss;
    __device__ __forceinline__ void operator()(const f32x4 (&acc)[2][2][4][2], const Unit& u, int wr, int wc, int fr, int fq) const {
        const int row0 = u.pm * BM + wr * 64 + fr; int colt = u.pn * BM;
        const bool isg = colt >= 8192;
        if (isg) colt -= 8192;
        const int col0 = colt + wc * 32 + 8 * fq;
        f32x4 bv[2][2];
#pragma unroll
        for (int bj = 0; bj < 2; ++bj)
#pragma unroll
            for (int n = 0; n < 2; ++n) bv[bj][n] = isg ? *(const f32x4*)(bgate + col0 + bj * HALF + 4 * n) : (f32x4){0.f, 0.f, 0.f, 0.f};
        const int bb = (u.pm * BM) >> 11, s0 = (row0 & 2047);
        float qs[2];
#pragma unroll
        for (int bj = 0; bj < 2; ++bj) { const int blk = (colt >> 7) + bj; qs[bj] = isg ? 1.0f : (blk < 8 ? 0.125f * 1.4426950408889634f : ((blk >= 24 && blk < 36) || blk >= 60) ? 0.08838834764831845f * 1.4426950408889634f : 1.0f); }
#pragma unroll
        for (int ai = 0; ai < 2; ++ai)
#pragma unroll
            for (int m = 0; m < 4; ++m) {
                const float rs = __builtin_amdgcn_rsqf((float)ss[row0 + ai * HALF + m * 16] * (1.0f / (2048.0f * 1048576.0f)) + 1e-5f);
#pragma unroll
                for (int bj = 0; bj < 2; ++bj) { const float rq = rs * qs[bj]; f32x4 v0 = acc[ai][bj][m][0] * rq + bv[bj][0], v1 = acc[ai][bj][m][1] * rq + bv[bj][1];
                    bf16_t* dst;
                    if (isg) { dst = gate + (size_t)(row0 + ai * HALF + m * 16) * 6144 + col0 + bj * HALF;
#pragma unroll
                        for (int i = 0; i < 4; ++i) { v0[i] = fmaxf(sigmoidf_(v0[i]), 1e-30f); v1[i] = fmaxf(sigmoidf_(v1[i]), 1e-30f); } }
                    else dst = qkv + (size_t)(((((colt >> 7) + bj) * 4 + bb) * 2048) + s0 + ai * HALF + m * 16) * 128 + wc * 32 + 8 * fq;
                    u32x4 w; w.x = cvt_pk_bf16(v0[0], v0[1]); w.y = cvt_pk_bf16(v0[2], v0[3]); w.z = cvt_pk_bf16(v1[0], v1[1]); w.w = cvt_pk_bf16(v1[2], v1[3]);
                    *(u32x4*)dst = w; } }
    }
};
struct EpiPlain {
    static constexpr bool PERM = true, AFTER_DRAIN = false, HAS_MID = false;
    bf16_t* O; int ldc;
    __device__ __forceinline__ void operator()(const f32x4 (&acc)[2][2][4][2], const Unit& u, int wr, int wc, int fr, int fq) const {
        const int row0 = u.pm * BM + wr * 64 + fr; const int col0 = u.pn * BM + wc * 32 + 8 * fq;
#pragma unroll
        for (int ai = 0; ai < 2; ++ai)
#pragma unroll
            for (int m = 0; m < 4; ++m) { bf16_t* rowp = O + (size_t)(row0 + ai * HALF + m * 16) * ldc + col0;
#pragma unroll
                for (int bj = 0; bj < 2; ++bj) { const f32x4 v0 = acc[ai][bj][m][0], v1 = acc[ai][bj][m][1];
                    u32x4 w; w.x = cvt_pk_bf16(v0[0], v0[1]); w.y = cvt_pk_bf16(v0[2], v0[3]); w.z = cvt_pk_bf16(v1[0], v1[1]); w.w = cvt_pk_bf16(v1[2], v1[3]);
                    *(u32x4*)(rowp + bj * HALF) = w; } }
    }
};
struct EpiProj {
    static constexpr bool PERM = true, AFTER_DRAIN = false, HAS_MID = true;
    const bf16_t* gate; bf16_t* merged;
    static __device__ __forceinline__ bool is_mid(int t) { return t == 16 || t == 24; }
    __device__ __forceinline__ void mid(f32x4 (&acc)[2][2][4][2], const Unit& u, int t, int wr, int wc, int fr, int fq) const {
        const int seg = (t == 16) ? 0 : 1;
        const int row0 = u.pm * BM + wr * 64 + fr; const int col0 = u.pn * BM + wc * 32 + 8 * fq;
        const bf16_t* gbase = gate + (size_t)row0 * 6144 + seg * 2048 + col0;
#pragma unroll
        for (int ai = 0; ai < 2; ++ai)
#pragma unroll
            for (int mh = 0; mh < 2; ++mh) {
                u32x4 a[2][2], b[2][2];
#pragma unroll
                for (int mm = 0; mm < 2; ++mm)
#pragma unroll
                    for (int bj = 0; bj < 2; ++bj) { const bf16_t* gp = gbase + (size_t)(ai * HALF + (mh * 2 + mm) * 16) * 6144 + bj * HALF; a[mm][bj] = *(const u32x4*)gp; b[mm][bj] = *(const u32x4*)(gp + 2048); }
#pragma unroll
                for (int mm = 0; mm < 2; ++mm)
#pragma unroll
                    for (int bj = 0; bj < 2; ++bj) { const int m = mh * 2 + mm; const u32x4 A = a[mm][bj], B = b[mm][bj];
                        f32x4 r0, r1;
                        r0[0] = bf_lo(A.x) * __builtin_amdgcn_rcpf(bf_lo(B.x)); r0[1] = bf_hi(A.x) * __builtin_amdgcn_rcpf(bf_hi(B.x));
                        r0[2] = bf_lo(A.y) * __builtin_amdgcn_rcpf(bf_lo(B.y)); r0[3] = bf_hi(A.y) * __builtin_amdgcn_rcpf(bf_hi(B.y));
                        r1[0] = bf_lo(A.z) * __builtin_amdgcn_rcpf(bf_lo(B.z)); r1[1] = bf_hi(A.z) * __builtin_amdgcn_rcpf(bf_hi(B.z));
                        r1[2] = bf_lo(A.w) * __builtin_amdgcn_rcpf(bf_lo(B.w)); r1[3] = bf_hi(A.w) * __builtin_amdgcn_rcpf(bf_hi(B.w));
                        acc[ai][bj][m][0] = acc[ai][bj][m][0] * r0; acc[ai][bj][m][1] = acc[ai][bj][m][1] * r1; }
                __builtin_amdgcn_sched_barrier(0);
            }
    }
    __device__ __forceinline__ void operator()(const f32x4 (&acc)[2][2][4][2], const Unit& u, int wr, int wc, int fr, int fq) const {
        const int row0 = u.pm * BM + wr * 64 + fr; const int col0 = u.pn * BM + wc * 32 + 8 * fq;
#pragma unroll
        for (int ai = 0; ai < 2; ++ai)
#pragma unroll
            for (int m = 0; m < 4; ++m) { const size_t r = (size_t)(row0 + ai * HALF + m * 16); const bf16_t* gp = gate + r * 6144 + 2 * 2048 + col0; bf16_t* rowp = merged + r * 2048 + col0;
#pragma unroll
                for (int bj = 0; bj < 2; ++bj) { const u32x4 g = *(const u32x4*)(gp + bj * HALF); const f32x4 v0 = acc[ai][bj][m][0], v1 = acc[ai][bj][m][1];
                    u32x4 w; w.x = cvt_pk_bf16(v0[0] * bf_lo(g.x), v0[1] * bf_hi(g.x)); w.y = cvt_pk_bf16(v0[2] * bf_lo(g.y), v0[3] * bf_hi(g.y));
                    w.z = cvt_pk_bf16(v1[0] * bf_lo(g.z), v1[1] * bf_hi(g.z)); w.w = cvt_pk_bf16(v1[2] * bf_lo(g.w), v1[3] * bf_hi(g.w));
                    *(u32x4*)(rowp + bj * HALF) = w; } }
    }
};
struct EpiResid {
    static constexpr bool PERM = true, AFTER_DRAIN = false, HAS_MID = false;
    const float* base32; bf16_t* xb; unsigned long long* ss;
    __device__ __forceinline__ void operator()(const f32x4 (&acc)[2][2][4][2], const Unit& u, int wr, int wc, int fr, int fq) const {
        const int row0 = u.pm * BM + wr * 64 + fr; const int col0 = u.pn * BM + wc * 32 + 8 * fq;
#pragma unroll
        for (int ai = 0; ai < 2; ++ai)
#pragma unroll
            for (int m = 0; m < 4; ++m) { const int row = row0 + ai * HALF + m * 16; const size_t off = (size_t)row * 2048 + col0; float sq = 0.f;
#pragma unroll
                for (int bj = 0; bj < 2; ++bj) { f32x4 b0, b1;
                    if (base32) { b0 = *(const f32x4*)(base32 + off + bj * HALF); b1 = *(const f32x4*)(base32 + off + bj * HALF + 4); }
                    else { const u32x4 p = *(const u32x4*)(xb + off + bj * HALF); b0 = (f32x4){bf_lo(p.x), bf_hi(p.x), bf_lo(p.y), bf_hi(p.y)}; b1 = (f32x4){bf_lo(p.z), bf_hi(p.z), bf_lo(p.w), bf_hi(p.w)}; }
                    const f32x4 v0 = b0 + acc[ai][bj][m][0], v1 = b1 + acc[ai][bj][m][1];
                    u32x4 w; w.x = cvt_pk_bf16(v0[0], v0[1]); w.y = cvt_pk_bf16(v0[2], v0[3]); w.z = cvt_pk_bf16(v1[0], v1[1]); w.w = cvt_pk_bf16(v1[2], v1[3]);
                    *(u32x4*)(xb + off + bj * HALF) = w;
                    const float r0 = bf_lo(w.x), r1 = bf_hi(w.x), r2 = bf_lo(w.y), r3 = bf_hi(w.y), r4 = bf_lo(w.z), r5 = bf_hi(w.z), r6 = bf_lo(w.w), r7 = bf_hi(w.w);
                    sq += ((r0 * r0 + r1 * r1) + (r2 * r2 + r3 * r3)) + ((r4 * r4 + r5 * r5) + (r6 * r6 + r7 * r7)); }
                sq += __shfl_xor(sq, 16); sq += __shfl_xor(sq, 32);
                if (fq == 0) (void)__hip_atomic_fetch_add(ss + row, (unsigned long long)(sq * 1048576.0f + 0.5f), __ATOMIC_RELAXED, __HIP_MEMORY_SCOPE_AGENT); }
    }
};
struct EpiSwiGLU {
    static constexpr bool PERM = true, AFTER_DRAIN = false, HAS_MID = false;
    bf16_t* hid; const unsigned long long* ss;
    __device__ __forceinline__ void operator()(const f32x4 (&acc)[2][2][4][2], const Unit& u, int wr, int wc, int fr, int fq) const {
        const int row0 = u.pm * BM + wr * 64 + fr; const int col0 = u.pn * HALF + wc * 32 + 8 * fq;
#pragma unroll
        for (int ai = 0; ai < 2; ++ai)
#pragma unroll
            for (int m = 0; m < 4; ++m) { bf16_t* rowp = hid + (size_t)(row0 + ai * HALF + m * 16) * 5632 + col0;
                f32x4 h0, h1; const float rs = __builtin_amdgcn_rsqf((float)ss[row0 + ai * HALF + m * 16] * (1.0f / (2048.0f * 1048576.0f)) + 1e-5f);
#pragma unroll
                for (int i = 0; i < 4; ++i) { const float g0 = acc[ai][0][m][0][i] * rs, g1 = acc[ai][0][m][1][i] * rs;
                    h0[i] = g0 * sigmoidf_(g0) * (acc[ai][1][m][0][i] * rs); h1[i] = g1 * sigmoidf_(g1) * (acc[ai][1][m][1][i] * rs); }
                u32x4 w; w.x = cvt_pk_bf16(h0[0], h0[1]); w.y = cvt_pk_bf16(h0[2], h0[3]); w.z = cvt_pk_bf16(h1[0], h1[1]); w.w = cvt_pk_bf16(h1[2], h1[3]);
                *(u32x4*)rowp = w; }
    }
};

template <class Epi, class Sched, bool ALIGN_EPI = false, bool SP2 = false>
__device__ __forceinline__ void gemm_phase(PG8_LAS unsigned char* lds, const Gemm g, const Sched& S, const Epi& E) {
    int tid = threadIdx.x; asm volatile("" : "+v"(tid));
    const int wid = __builtin_amdgcn_readfirstlane(tid >> 6), lane = tid & 63, wr = wid >> 2, wc = wid & 3, fr = lane & 15, fq = lane >> 4;
    const int K = g.K, nt = K / BK;
    unsigned voffA[2], voffB[2];
#pragma unroll
    for (int i = 0; i < 2; ++i) { int R, C; stage_rc(tid * 16 + i * 8192, R, C); const int Rb = Epi::PERM ? ((R & ~31) + perm32(R & 31)) : R;
        voffA[i] = (unsigned)(R * K + C) * 2u; voffB[i] = (unsigned)(Rb * K + C) * 2u; }
    const size_t kstep = (size_t)(BK * 2);
    const size_t hstep = (size_t)HALF * K * 2;
    const size_t tstep = 2 * hstep;
    const unsigned ldsw = (unsigned)wid * 1024u;
    const int aoff = lds_byte(wr * 64 + fr, fq * 8), boff = lds_byte(wc * 32 + fr, fq * 8);
#define PG8_SA(b, h) (((b) * 2 + (h)) * HTB)
#define PG8_SB(b, h) ((4 + (b) * 2 + (h)) * HTB)
#define PG8_STAGE(bufoff, gbase, voff) do { _Pragma("unroll") for (int _i = 0; _i < 2; ++_i) \
        __builtin_amdgcn_global_load_lds((const unsigned*)((const char*)(gbase) + (voff)[_i]), (PG8_LAS unsigned*)(lds + (bufoff) + ldsw + _i * 8192), 16, 0, 0); } while (0)
#define PG8_LDA(dst, b, h) do { _Pragma("unroll") for (int m = 0; m < 4; ++m) _Pragma("unroll") for (int k = 0; k < 2; ++k) dst[m][k] = *(const PG8_LAS bf16x8*)(lds + PG8_SA(b, h) + aoff + m * 2048 + k * 1024); } while (0)
#define PG8_LDB(dst, b, h) do { _Pragma("unroll") for (int n = 0; n < 2; ++n) _Pragma("unroll") for (int k = 0; k < 2; ++k) dst[n][k] = *(const PG8_LAS bf16x8*)(lds + PG8_SB(b, h) + boff + n * 2048 + k * 1024); } while (0)
#define PG8_MMA(ai, bj, At, Bt) do { __builtin_amdgcn_s_setprio(1); _Pragma("unroll") for (int m = 0; m < 4; ++m) _Pragma("unroll") for (int n = 0; n < 2; ++n) _Pragma("unroll") for (int k = 0; k < 2; ++k) \
        acc[ai][bj][m][n] = __builtin_amdgcn_mfma_f32_16x16x32_bf16(Bt[n][k], At[m][k], acc[ai][bj][m][n], 0, 0, 0); __builtin_amdgcn_s_setprio(0); } while (0)
#define PG8_WAIT_V(n) asm volatile("s_waitcnt vmcnt(" #n ")" ::: "memory")
#define PG8_WAIT_L(n) asm volatile("s_waitcnt lgkmcnt(" #n ")" ::: "memory")
#define PG8_BAR __builtin_amdgcn_s_barrier()
#define PG8_SCHED __builtin_amdgcn_sched_barrier(0)
    Unit cur, nxt; int ui = 0;
    if (!S.next(0, cur)) return;
    f32x4 acc[2][2][4][2];
#pragma unroll
    for (int a = 0; a < 2; ++a)
#pragma unroll
        for (int b = 0; b < 2; ++b)
#pragma unroll
            for (int m = 0; m < 4; ++m)
#pragma unroll
                for (int n = 0; n < 2; ++n) acc[a][b][m][n] = (f32x4){0.f, 0.f, 0.f, 0.f};
    bf16x8 At[4][2], B0[2][2], B1[2][2];
    const char* cA = (const char*)g.A + (size_t)cur.pm * tstep; const char* cB = (const char*)g.Bt + (size_t)cur.pn * tstep;
    S.a_ready(cur);
    if constexpr (SP2) {
        PG8_STAGE(PG8_SB(0, 0), cB, voffB); PG8_STAGE(PG8_SB(0, 1), cB + hstep, voffB); PG8_STAGE(PG8_SA(0, 0), cA, voffA); PG8_STAGE(PG8_SA(0, 1), cA + hstep, voffA);
        if (wr == 1) PG8_BAR;
        PG8_WAIT_V(2); PG8_BAR;
        PG8_STAGE(PG8_SB(1, 0), cB + kstep, voffB); PG8_STAGE(PG8_SA(1, 0), cA + kstep, voffA); PG8_STAGE(PG8_SB(1, 1), cB + hstep + kstep, voffB);
        PG8_WAIT_V(6); PG8_BAR;
    } else {
        PG8_STAGE(PG8_SB(0, 0), cB, voffB); PG8_STAGE(PG8_SA(0, 0), cA, voffA); PG8_STAGE(PG8_SB(0, 1), cB + hstep, voffB); PG8_STAGE(PG8_SA(0, 1), cA + hstep, voffA);
        if (wr == 1) PG8_BAR;
        PG8_WAIT_V(4); PG8_BAR;
        PG8_STAGE(PG8_SB(1, 0), cB + kstep, voffB); PG8_STAGE(PG8_SA(1, 0), cA + kstep, voffA); PG8_STAGE(PG8_SB(1, 1), cB + hstep + kstep, voffB);
        PG8_WAIT_V(6); PG8_BAR;
    }
    for (;;) {
        const bool has_next = S.next(ui + 1, nxt);
        const char* nA = has_next ? (const char*)g.A + (size_t)nxt.pm * tstep : cA; const char* nB = has_next ? (const char*)g.Bt + (size_t)nxt.pn * tstep : cB;
        for (int t = 0; t < nt; t += 2) {
            const bool last = (t == nt - 2);
            const char* a1 = cA + (size_t)(t + 1) * kstep;
            const char* a2 = last ? nA : cA + (size_t)(t + 2) * kstep; const char* b2 = last ? nB : cB + (size_t)(t + 2) * kstep;
            const char* a3 = a2 + kstep; const char* b3 = b2 + kstep;
            if (last && has_next) S.a_ready(nxt);
            if constexpr (Epi::HAS_MID) { if (Epi::is_mid(t)) E.mid(acc, cur, t, wr, wc, fr, fq); }
            if constexpr (SP2) {
            PG8_LDB(B0, 0, 0); PG8_LDB(B1, 0, 1); PG8_SCHED; PG8_LDA(At, 0, 0); PG8_STAGE(PG8_SA(1, 1), a1 + hstep, voffA);
            PG8_WAIT_V(8); PG8_WAIT_L(0); PG8_BAR; PG8_MMA(0, 0, At, B0); PG8_MMA(0, 1, At, B1); PG8_BAR; PG8_SCHED;
            PG8_LDA(At, 0, 1); PG8_STAGE(PG8_SB(0, 0), b2, voffB); PG8_STAGE(PG8_SB(0, 1), b2 + hstep, voffB); PG8_STAGE(PG8_SA(0, 0), a2, voffA);
            PG8_WAIT_V(8); PG8_WAIT_L(0); PG8_BAR; PG8_MMA(1, 0, At, B0); PG8_MMA(1, 1, At, B1); PG8_BAR; PG8_SCHED;
            PG8_LDB(B0, 1, 0); PG8_LDB(B1, 1, 1); PG8_SCHED; PG8_LDA(At, 1, 0); PG8_STAGE(PG8_SA(0, 1), a2 + hstep, voffA);
            PG8_WAIT_V(8); PG8_WAIT_L(0); PG8_BAR; PG8_MMA(0, 0, At, B0); PG8_MMA(0, 1, At, B1); PG8_BAR; PG8_SCHED;
            PG8_LDA(At, 1, 1); PG8_STAGE(PG8_SB(1, 0), b3, voffB); PG8_STAGE(PG8_SB(1, 1), b3 + hstep, voffB); PG8_STAGE(PG8_SA(1, 0), a3, voffA);
            PG8_WAIT_V(8); PG8_WAIT_L(0); PG8_BAR; PG8_MMA(1, 0, At, B0); PG8_MMA(1, 1, At, B1); PG8_BAR; PG8_SCHED;
            } else {
            PG8_LDB(B0, 0, 0); PG8_SCHED; PG8_LDA(At, 0, 0); PG8_STAGE(PG8_SA(1, 1), a1 + hstep, voffA);
            PG8_WAIT_L(8); PG8_BAR; PG8_WAIT_L(0); PG8_MMA(0, 0, At, B0); PG8_BAR; PG8_SCHED;
            PG8_LDB(B1, 0, 1); PG8_STAGE(PG8_SB(0, 0), b2, voffB);
            PG8_BAR; PG8_WAIT_L(0); PG8_MMA(0, 1, At, B1); PG8_BAR;
            PG8_LDA(At, 0, 1); PG8_STAGE(PG8_SA(0, 0), a2, voffA);
            PG8_BAR; PG8_WAIT_L(0); PG8_MMA(1, 0, At, B0); PG8_BAR; PG8_SCHED;
            PG8_STAGE(PG8_SB(0, 1), b2 + hstep, voffB);
            PG8_WAIT_V(6); PG8_BAR; PG8_MMA(1, 1, At, B1); PG8_BAR;
            PG8_LDB(B0, 1, 0); PG8_SCHED; PG8_LDA(At, 1, 0); PG8_STAGE(PG8_SA(0, 1), a2 + hstep, voffA);
            PG8_WAIT_L(8); PG8_BAR; PG8_WAIT_L(0); PG8_MMA(0, 0, At, B0); PG8_BAR; PG8_SCHED;
            PG8_LDB(B1, 1, 1); PG8_STAGE(PG8_SB(1, 0), b3, voffB);
            PG8_BAR; PG8_WAIT_L(0); PG8_MMA(0, 1, At, B1); PG8_BAR;
            PG8_LDA(At, 1, 1); PG8_STAGE(PG8_SA(1, 0), a3, voffA);
            PG8_BAR; PG8_WAIT_L(0); PG8_MMA(1, 0, At, B0); PG8_BAR; PG8_SCHED;
            PG8_STAGE(PG8_SB(1, 1), b3 + hstep, voffB);
            PG8_WAIT_V(6); PG8_BAR; PG8_MMA(1, 1, At, B1); PG8_BAR;
            }
        }
        if constexpr (ALIGN_EPI) { if (wr == 0) PG8_BAR; }
        if constexpr (!Epi::AFTER_DRAIN) { E(acc, cur, wr, wc, fr, fq); S.done(cur); }
        if (!has_next) break;
#pragma unroll
        for (int a = 0; a < 2; ++a)
#pragma unroll
            for (int b = 0; b < 2; ++b)
#pragma unroll
                for (int m = 0; m < 4; ++m)
#pragma unroll
                    for (int n = 0; n < 2; ++n) acc[a][b][m][n] = (f32x4){0.f, 0.f, 0.f, 0.f};
        cur = nxt; cA = nA; cB = nB; ++ui;
        if constexpr (ALIGN_EPI) { if (wr == 1) PG8_BAR; }
    }
    PG8_WAIT_V(0);
    if constexpr (!ALIGN_EPI) { if (wr == 0) PG8_BAR; }
    PG8_BAR;
#undef PG8_SA
#undef PG8_SB
#undef PG8_STAGE
#undef PG8_LDA
#undef PG8_LDB
#undef PG8_MMA
#undef PG8_WAIT_V
#undef PG8_WAIT_L
#undef PG8_BAR
#undef PG8_SCHED
}
}

constexpr int DM = 2048, NB = 4, SEQ = 2048, DEPTH = 4, MTOK = NB * SEQ;
constexpr int MEML = 256, NIN = 8192, NGATE = 6144, DFF = 5632;
constexpr float EPS = 1e-5f;
constexpr float LOG2E = 1.4426950408889634f;
#define QKV_AT(b_, s_, col_) ((size_t)(((((col_) >> 7) * NB + (b_)) * SEQ + (s_))) * 128 + ((col_) & 127))
constexpr int C_QA = 0, C_KA = 1024, C_VA = 2048, C_QB = 3072, C_KB = 4608, C_VB = 6144, C_QC = 7680;

typedef unsigned short bf16;
typedef unsigned v4u __attribute__((ext_vector_type(4)));
typedef unsigned v2u __attribute__((ext_vector_type(2)));
typedef float f32x4 __attribute__((ext_vector_type(4)));
#define LAS __attribute__((address_space(3)))

namespace att {
__device__ __forceinline__ int ltid() { int t = threadIdx.x; asm volatile("" : "+v"(t)); return t; }
using bf16x8 = __attribute__((ext_vector_type(8))) short;
using s16x4  = __attribute__((ext_vector_type(4))) short;
using f32x16 = __attribute__((ext_vector_type(16))) float;
using u32x4  = __attribute__((ext_vector_type(4))) unsigned;
constexpr int NW = 8, QBLK = 32, KVBLK = 64;
constexpr int SHM_V = 16384, SHM_K = 16384;
constexpr int OFF_V = 0, OFF_K = 32768, OFF_WS = 65536, OFF_TAB = 65536 + 2048;
constexpr float THR2 = 11.5f;
#define KSWZ(row, colB) ((row) * 256 + ((colB) ^ (((row) & 7) << 4)))
#define SBAR() __builtin_amdgcn_sched_barrier(0)
__device__ __forceinline__ int crow(int r, int hi) { return (r & 3) + 8 * (r >> 2) + 4 * hi; }
__device__ __forceinline__ unsigned cvtpk(float lo, float hi) { unsigned r; asm volatile("v_cvt_pk_bf16_f32 %0, %1, %2" : "=v"(r) : "v"(lo), "v"(hi)); return r; }
__device__ __forceinline__ bf16x8 ld8(const bf16* p) { return *reinterpret_cast<const bf16x8*>(p); }

__device__ __forceinline__ void partialSM(f32x16& p0, f32x16& p1, float& m_reg, float& mn, float& alpha) {
  float pmax = p0[0];
#pragma unroll
  for (int r = 1; r < 16; ++r) pmax = fmaxf(pmax, p0[r]);
#pragma unroll
  for (int r = 0; r < 16; ++r) pmax = fmaxf(pmax, p1[r]);
  { auto rr = __builtin_amdgcn_permlane32_swap(__float_as_uint(pmax), __float_as_uint(pmax), false, false);
    pmax = fmaxf(__uint_as_float(rr[0]), __uint_as_float(rr[1])); }
  if (__builtin_expect(__all(pmax - m_reg <= THR2), 1)) { mn = m_reg; alpha = 1.f; }
  else { mn = fmaxf(m_reg, pmax); alpha = __builtin_amdgcn_exp2f(m_reg - mn); m_reg = mn; }
#pragma unroll
  for (int r = 0; r < 16; ++r) p0[r] = p0[r] - mn;
#pragma unroll
  for (int r = 0; r < 16; ++r) p1[r] = p1[r] - mn;
#pragma unroll
  for (int r = 0; r < 16; ++r) p0[r] = __builtin_amdgcn_exp2f(p0[r]);
}
__device__ __forceinline__ void finishSM(f32x16& p0, f32x16& p1, float alpha, float& l_reg, bf16x8& pa0, bf16x8& pa1, bf16x8& pa2, bf16x8& pa3) {
#pragma unroll
  for (int r = 0; r < 16; ++r) p1[r] = __builtin_amdgcn_exp2f(p1[r]);
  float ps = 0;
#pragma unroll
  for (int r = 0; r < 16; ++r) ps += p0[r];
#pragma unroll
  for (int r = 0; r < 16; ++r) ps += p1[r];
  { auto rr = __builtin_amdgcn_permlane32_swap(__float_as_uint(ps), __float_as_uint(ps), false, false);
    ps = __uint_as_float(rr[0]) + __uint_as_float(rr[1]); }
  l_reg = l_reg * alpha + ps;
#define PK4(P, BASE, OUT) do { unsigned a0 = cvtpk(P[BASE + 0], P[BASE + 1]), a1 = cvtpk(P[BASE + 2], P[BASE + 3]);   \
    unsigned b0 = cvtpk(P[BASE + 4], P[BASE + 5]), b1 = cvtpk(P[BASE + 6], P[BASE + 7]);                              \
    auto r0 = __builtin_amdgcn_permlane32_swap(a0, b0, false, false); auto r1 = __builtin_amdgcn_permlane32_swap(a1, b1, false, false); \
    u32x4 w = {r0[0], r1[0], r0[1], r1[1]}; OUT = *reinterpret_cast<bf16x8*>(&w); } while (0)
  PK4(p0, 0, pa0); PK4(p0, 8, pa1); PK4(p1, 0, pa2); PK4(p1, 8, pa3);
#undef PK4
}
template <int ND> __device__ __forceinline__ void qkt(f32x16& p0, f32x16& p1, const bf16* Ks, const bf16x8* qr, int doff, int r32, int hi) {
#pragma unroll
  for (int d0 = 0; d0 < ND; ++d0) { const int cb = ((doff + d0) * 16 + hi * 8) * 2;
    bf16x8 b0 = *reinterpret_cast<const bf16x8*>((const char*)Ks + KSWZ(r32, cb));
    bf16x8 b1 = *reinterpret_cast<const bf16x8*>((const char*)Ks + KSWZ(32 + r32, cb));
    p0 = __builtin_amdgcn_mfma_f32_32x32x16_bf16(b0, qr[d0], p0, 0, 0, 0);
    p1 = __builtin_amdgcn_mfma_f32_32x32x16_bf16(b1, qr[d0], p1, 0, 0, 0); }
}
__device__ __forceinline__ int v_st(int k, int c) { const int kk = (k & ~0xC) | ((k & 4) << 1) | ((k & 8) >> 1); return ((kk >> 3) * 4 + (c >> 5)) * 512 + ((kk & 7) * 32 + (c & 31)) * 2; }
__device__ __forceinline__ int v_rd_base(int lane) { return ((lane & 3) << 3) | (((lane >> 2) & 3) << 6) | (((lane >> 4) & 1) << 5) | (((lane >> 5) & 1) << 8); }
constexpr int v_rd_off(int d0, int ks, int half) { return d0 * 512 + ks * 4096 + half * 2048; }
template <int OFF> __device__ __forceinline__ s16x4 tr_read(int vb) {
  s16x4 r; asm volatile("ds_read_b64_tr_b16 %0, %1 offset:%2" : "=&v"(r) : "v"(vb), "i"(OFF) : "memory"); return r;
}
template <int D0> __device__ __forceinline__ void pv_one(f32x16& od, int vb, bf16x8 pa0, bf16x8 pa1, bf16x8 pa2, bf16x8 pa3) {
  const s16x4 l0 = tr_read<v_rd_off(D0, 0, 0)>(vb), h0 = tr_read<v_rd_off(D0, 0, 1)>(vb), l1 = tr_read<v_rd_off(D0, 1, 0)>(vb), h1 = tr_read<v_rd_off(D0, 1, 1)>(vb);
  const s16x4 l2 = tr_read<v_rd_off(D0, 2, 0)>(vb), h2 = tr_read<v_rd_off(D0, 2, 1)>(vb), l3 = tr_read<v_rd_off(D0, 3, 0)>(vb), h3 = tr_read<v_rd_off(D0, 3, 1)>(vb);
  asm volatile("s_waitcnt lgkmcnt(0)" ::: "memory"); SBAR();
#define PK(L, H) (bf16x8){L[0], L[1], L[2], L[3], H[0], H[1], H[2], H[3]}
  od = __builtin_amdgcn_mfma_f32_32x32x16_bf16(pa0, PK(l0, h0), od, 0, 0, 0);
  od = __builtin_amdgcn_mfma_f32_32x32x16_bf16(pa1, PK(l1, h1), od, 0, 0, 0);
  od = __builtin_amdgcn_mfma_f32_32x32x16_bf16(pa2, PK(l2, h2), od, 0, 0, 0);
  od = __builtin_amdgcn_mfma_f32_32x32x16_bf16(pa3, PK(l3, h3), od, 0, 0, 0);
#undef PK
}
__device__ __forceinline__ void pv_d0(f32x16* o, int vb, bf16x8 pa0, bf16x8 pa1, bf16x8 pa2, bf16x8 pa3) {
  pv_one<0>(o[0], vb, pa0, pa1, pa2, pa3); pv_one<1>(o[1], vb, pa0, pa1, pa2, pa3); pv_one<2>(o[2], vb, pa0, pa1, pa2, pa3); pv_one<3>(o[3], vb, pa0, pa1, pa2, pa3);
}

__device__ __forceinline__ int rel_bucket(int rel) {
  const int n = rel < 0 ? -rel : rel;
  const int v = n < 8 ? n : (n < 15 ? 8 : (n < 27 ? 9 : (n < 50 ? 10 : (n < 91 ? 11 : (n < 166 ? 12 : (n < 305 ? 13 : (n < 559 ? 14 : 15)))))));
  return (rel > 0 ? 16 : 0) + v;
}

template <class P> __device__ __forceinline__ void attn_unit(P& pol, char* lds) {
  const int tid = ltid(), wid = tid >> 6, lane = tid & 63, r32 = lane & 31, hi = lane >> 5;
  bf16* V_lds = (bf16*)(lds + OFF_V); bf16* K_lds = (bf16*)(lds + OFF_K);
  float* ws = (float*)(lds + OFF_WS) + wid * 64; float* li_l = ws; float* al_l = ws + 32;
  float m_reg = -1e30f, l_reg = 0; f32x16 o[4] = {}; bf16x8 qr[P::ND];
  const bf16* Qw = pol.qptr() + hi * 8;
#pragma unroll
  for (int d0 = 0; d0 < P::ND; ++d0) qr[d0] = ld8(Qw + d0 * 16);
  const int sr = tid >> 4, sc = (tid & 15) * 8, vst0 = v_st(sr, sc), vst1 = v_st(32 + sr, sc);
  const int vb0 = (int)(uintptr_t)V_lds + v_rd_base(lane);
  const int doff = pol.doff();
  struct { bf16x8 vs0, vs1, ks0, ks1; } sr_[1];
#define SLOAD(i, t) do { sr_[i].vs0 = ld8(pol.vrow((t), sr) + sc); sr_[i].vs1 = ld8(pol.vrow((t), 32 + sr) + sc); \
    sr_[i].ks0 = ld8(pol.krow((t), sr) + sc); sr_[i].ks1 = ld8(pol.krow((t), 32 + sr) + sc); } while (0)
#define SWRITE(b, i) do { *(bf16x8*)((char*)V_lds + (b) * SHM_V + vst0) = sr_[i].vs0;          \
    *(bf16x8*)((char*)V_lds + (b) * SHM_V + vst1) = sr_[i].vs1; int kc = sc * 2;               \
    *(bf16x8*)((char*)K_lds + (b) * SHM_K + KSWZ(sr, kc)) = sr_[i].ks0;                       \
    *(bf16x8*)((char*)K_lds + (b) * SHM_K + KSWZ(32 + sr, kc)) = sr_[i].ks1; } while (0)
#define RESC(a) do { if (__any((a) < 1.f)) { if (hi == 0) al_l[r32] = (a); asm volatile("s_waitcnt lgkmcnt(0)" ::: "memory"); \
    _Pragma("unroll") for (int d = 0; d < 4; ++d) _Pragma("unroll") for (int r = 0; r < 16; ++r) o[d][r] *= al_l[crow(r, hi)]; } } while (0)
  s16x4 vA[8], vB[8];
#define VRD8(dst, vb, D0) do { dst[0] = tr_read<v_rd_off(D0, 0, 0)>(vb); dst[1] = tr_read<v_rd_off(D0, 0, 1)>(vb); dst[2] = tr_read<v_rd_off(D0, 1, 0)>(vb); dst[3] = tr_read<v_rd_off(D0, 1, 1)>(vb); \
    dst[4] = tr_read<v_rd_off(D0, 2, 0)>(vb); dst[5] = tr_read<v_rd_off(D0, 2, 1)>(vb); dst[6] = tr_read<v_rd_off(D0, 3, 0)>(vb); dst[7] = tr_read<v_rd_off(D0, 3, 1)>(vb); } while (0)
#define PKV(L, H) (bf16x8){L[0], L[1], L[2], L[3], H[0], H[1], H[2], H[3]}
#define PVM(od, src) do { od = __builtin_amdgcn_mfma_f32_32x32x16_bf16(pa0, PKV(src[0], src[1]), od, 0, 0, 0); od = __builtin_amdgcn_mfma_f32_32x32x16_bf16(pa1, PKV(src[2], src[3]), od, 0, 0, 0); \
    od = __builtin_amdgcn_mfma_f32_32x32x16_bf16(pa2, PKV(src[4], src[5]), od, 0, 0, 0); od = __builtin_amdgcn_mfma_f32_32x32x16_bf16(pa3, PKV(src[6], src[7]), od, 0, 0, 0); } while (0)
#define LW(n) asm volatile("s_waitcnt lgkmcnt(" #n ")" ::: "memory")
#define PVREST(vb) do { SBAR(); VRD8(vB, (vb), 1); LW(8); SBAR(); PVM(o[0], vA); SBAR(); VRD8(vA, (vb), 2); LW(8); SBAR(); PVM(o[1], vB); SBAR(); \
    VRD8(vB, (vb), 3); LW(8); SBAR(); PVM(o[2], vA); SBAR(); LW(0); SBAR(); PVM(o[3], vB); SBAR(); } while (0)
  f32x16 pA0, pA1, pB0, pB1; float mnA, mnB, alA, alB; bf16x8 pa0, pa1, pa2, pa3; constexpr int NT = P::NT;
  SLOAD(0, 0);
  pol.prep(lds);
  asm volatile("s_waitcnt vmcnt(0)" ::: "memory"); SWRITE(0, 0); __syncthreads();
  SLOAD(0, 1);
  pol.init_scores(pA0, pA1, 0); qkt<P::ND>(pA0, pA1, K_lds, qr, doff, r32, hi); partialSM(pA0, pA1, m_reg, mnA, alA);
  SWRITE(1, 0); __syncthreads();
  for (int j = 1; j + 1 < NT; j += 2) {
    SBAR(); SLOAD(0, j + 1); SBAR();
    pol.init_scores(pB0, pB1, j); qkt<P::ND>(pB0, pB1, (bf16*)((char*)K_lds + SHM_K), qr, doff, r32, hi);
    SBAR(); VRD8(vA, vb0, 0); SBAR();
    finishSM(pA0, pA1, alA, l_reg, pa0, pa1, pa2, pa3);
    PVREST(vb0);
    partialSM(pB0, pB1, m_reg, mnB, alB);
    __syncthreads(); SWRITE(0, 0);
    RESC(alB); __syncthreads();
    SBAR(); SLOAD(0, j + 2); SBAR();
    pol.init_scores(pA0, pA1, j + 1); qkt<P::ND>(pA0, pA1, K_lds, qr, doff, r32, hi);
    SBAR(); VRD8(vA, vb0 + (int)SHM_V, 0); SBAR();
    finishSM(pB0, pB1, alB, l_reg, pa0, pa1, pa2, pa3);
    PVREST(vb0 + (int)SHM_V);
    partialSM(pA0, pA1, m_reg, mnA, alA);
    __syncthreads(); SWRITE(1, 0);
    RESC(alA); __syncthreads();
  }
  SBAR(); pol.init_scores(pB0, pB1, NT - 1); qkt<P::ND>(pB0, pB1, (bf16*)((char*)K_lds + SHM_K), qr, doff, r32, hi);
  SBAR(); VRD8(vA, vb0, 0); SBAR();
  finishSM(pA0, pA1, alA, l_reg, pa0, pa1, pa2, pa3);
  PVREST(vb0);
  partialSM(pB0, pB1, m_reg, mnB, alB);
  RESC(alB);
  SBAR(); VRD8(vA, vb0 + (int)SHM_V, 0); SBAR();
  finishSM(pB0, pB1, alB, l_reg, pa0, pa1, pa2, pa3);
  PVREST(vb0 + (int)SHM_V);
#undef VRD8
#undef PKV
#undef PVM
#undef LW
#undef PVREST
  pol.epilogue(o, m_reg, l_reg, li_l, lds);
#undef SLOAD
#undef SWRITE
#undef RESC
}


#define ATT_STORE_TILE(stg_, VAL, ROWPTR) do { unsigned short* stg__ = (unsigned short*)(stg_); \
    _Pragma("unroll") for (int r = 0; r < 16; ++r) { const int row__ = crow(r, hi); \
      _Pragma("unroll") for (int d = 0; d < 4; ++d) { const float v__ = (VAL); stg__[row__ * 128 + d * 32 + r32] = (unsigned short)(cvtpk(v__, v__) & 0xffffu); } \
      if ((r & 3) == 3) __builtin_amdgcn_sched_barrier(0); } \
    asm volatile("s_waitcnt lgkmcnt(0)" ::: "memory"); \
    const int ln__ = (ltid() & 63); \
    _Pragma("unroll") for (int i = 0; i < 8; ++i) { const int row = 4 * i + (ln__ >> 4); const u32x4 w__ = *(const u32x4*)(stg__ + row * 128 + (ln__ & 15) * 8); \
      *(u32x4*)((ROWPTR) + (ln__ & 15) * 8) = w__; if (i & 1) __builtin_amdgcn_sched_barrier(0); } } while (0)

struct PolA {
  static constexpr int ND = 4, NT = SEQ / KVBLK;
  const bf16* qkv; bf16* obuf; const float* subg; float lam, post;
  int b, h, q0, qg, m, r32, hi; const float* tp0;
  const float* relb_;
  __device__ __forceinline__ void init(const bf16* qkv_, bf16* obuf_, const float* subg_, float lam_, float post_, int b_, int h_, int q0_, const float* relb, char* lds) {
    qkv = qkv_; obuf = obuf_; subg = subg_; lam = lam_; post = post_; b = b_; h = h_; q0 = q0_; relb_ = relb;
    const int tid = ltid(), wid = tid >> 6, lane = tid & 63; qg = wid >> 1; m = wid & 1; r32 = lane & 31; hi = lane >> 5;
    float* tab = (float*)(lds + OFF_TAB);
    const int sq = q0 + 32 * qg + r32;
    tp0 = tab + m * 4096 + (4 * hi - sq + 2047);
  }
  __device__ __forceinline__ void prep(char* lds) const {
    const int tid = ltid(); float* tab = (float*)(lds + OFF_TAB); float* colv = tab + 8192;
    if (tid < 64) colv[tid] = relb_[(tid & 31) * 28 + (tid >> 5) * 8 + h] * LOG2E;
    __syncthreads();
#pragma unroll 4
    for (int i = tid; i < 2 * 4096; i += 512) { const int mm = i >> 12, rel = (i & 4095) - 2047; tab[i] = colv[mm * 32 + rel_bucket(rel)]; }
  }
  __device__ __forceinline__ const bf16* qptr() const { return qkv + QKV_AT(b, q0 + 32 * qg + r32, C_QA + h * 128 + m * 64); }
  __device__ __forceinline__ const bf16* krow(int t, int row) const { return qkv + QKV_AT(b, 64 * t + row, C_KA + h * 128); }
  __device__ __forceinline__ const bf16* vrow(int t, int row) const { return qkv + QKV_AT(b, 64 * t + row, C_VA + h * 128); }
  __device__ __forceinline__ int doff() const { return 4 * m; }
  __device__ __forceinline__ void init_scores(f32x16& p0, f32x16& p1, int t) const {
    const float* tp = tp0 + 64 * t;
#pragma unroll
    for (int r = 0; r < 16; ++r) { p0[r] = tp[(r & 3) + 8 * (r >> 2)]; p1[r] = tp[32 + (r & 3) + 8 * (r >> 2)]; }
  }
  __device__ __forceinline__ void epilogue(f32x16* o, float m_reg, float l_reg, float* li_l, char* lds) const {
    if (hi == 0) li_l[r32] = l_reg; asm volatile("s_waitcnt lgkmcnt(0)" ::: "memory");
    const float sc = m ? lam : 1.0f;
#pragma unroll
    for (int r = 0; r < 16; ++r) { const float rl = __builtin_amdgcn_rcpf(li_l[crow(r, hi)]) * sc;
#pragma unroll
      for (int d = 0; d < 4; ++d) o[d][r] *= rl; }
    __syncthreads();
    float* X = (float*)lds; const int lane = ltid() & 63;
    if (m == 1) {
#pragma unroll
      for (int d = 0; d < 4; ++d)
#pragma unroll
        for (int r = 0; r < 16; ++r) X[((qg * 4 + d) * 16 + r) * 64 + lane] = o[d][r];
    }
    __syncthreads();
    if (m == 0) {
      float ss[16];
#pragma unroll
      for (int r = 0; r < 16; ++r) { float s = 0.f;
#pragma unroll
        for (int d = 0; d < 4; ++d) { o[d][r] -= X[((qg * 4 + d) * 16 + r) * 64 + lane]; s += o[d][r] * o[d][r]; }
        ss[r] = s; }
#pragma unroll
      for (int off = 1; off < 32; off <<= 1)
#pragma unroll
        for (int r = 0; r < 16; ++r) ss[r] += __shfl_xor(ss[r], off);
      float gsub[4]; unsigned pbits = __float_as_uint(post); asm volatile("" : "+s"(pbits));
      const float oscale = 1.0f - __uint_as_float(pbits);
#pragma unroll
      for (int d = 0; d < 4; ++d) gsub[d] = subg[d * 32 + r32] * oscale;
      float rn[16];
#pragma unroll
      for (int r = 0; r < 16; ++r) rn[r] = __builtin_amdgcn_rsqf(ss[r] * (1.0f / 128.0f) + EPS);
      ATT_STORE_TILE(lds + OFF_TAB + qg * 8192, o[d][r] * rn[r] * gsub[d], obuf + (size_t)(b * SEQ + q0 + 32 * qg + row) * DM + h * 128);
    }
    __syncthreads();
  }
};

struct PolB {
  static constexpr int ND = 8, NT = 6;
  const bf16* qkv; bf16* ob; float* lse;
  int b, g, hb, P0, l2L, dsh, pq, lo, hi_, r32, hi, wid; const float* tp0;
  __device__ __forceinline__ int tok(int p) const { return ((p & ((1 << l2L) - 1)) << dsh) + (p >> l2L); }
  const float* relb_;
  __device__ __forceinline__ void init(const bf16* qkv_, bf16* ob_, float* lse_, int b_, int g_, int hb_, int P0_, const float* relb, char* lds) {
    qkv = qkv_; ob = ob_; lse = lse_; b = b_; g = g_; hb = hb_; P0 = P0_; dsh = 2 * g; l2L = 11 - dsh; relb_ = relb;
    const int tid = ltid(), lane = tid & 63; wid = tid >> 6; r32 = lane & 31; hi = lane >> 5;
    float* tab = (float*)(lds + OFF_TAB);
    pq = P0 + 32 * wid + r32;
    const int cs = (pq >> l2L) << l2L, ce = cs + (1 << l2L) - 1;
    lo = pq - 64 > cs ? pq - 64 : cs; hi_ = pq + 64 < ce ? pq + 64 : ce;
    tp0 = tab + (P0 - 64 + 4 * hi - pq + 320);
  }
  __device__ __forceinline__ void prep(char* lds) const {
    const int tid = ltid(); float* tab = (float*)(lds + OFF_TAB); float* colv = tab + 8192;
    if (tid < 32) colv[tid] = relb_[tid * 28 + 16 + 4 * g + hb] * LOG2E;
    __syncthreads();
    for (int i = tid; i < 640; i += 512) { const int dp = i - 320; tab[i] = (dp >= -64 && dp <= 64) ? colv[rel_bucket(dp * (1 << dsh))] : 0.f; }
  }
  __device__ __forceinline__ const bf16* qptr() const { return qkv + QKV_AT(b, tok(pq), C_QB + g * 512 + hb * 128); }
  __device__ __forceinline__ const bf16* krow(int t, int row) const { int p = P0 - 64 + 64 * t + row; p = p < 0 ? 0 : (p > SEQ - 1 ? SEQ - 1 : p);
    return qkv + QKV_AT(b, tok(p), C_KB + g * 512 + hb * 128); }
  __device__ __forceinline__ const bf16* vrow(int t, int row) const { int p = P0 - 64 + 64 * t + row; p = p < 0 ? 0 : (p > SEQ - 1 ? SEQ - 1 : p);
    return qkv + QKV_AT(b, tok(p), C_VB + g * 512 + hb * 128); }
  __device__ __forceinline__ int doff() const { return 0; }
  __device__ __forceinline__ void init_scores(f32x16& p0, f32x16& p1, int t) const {
    const float* tp = tp0 + 64 * t; const int kp0 = P0 - 64 + 64 * t + 4 * hi;
#pragma unroll
    for (int r = 0; r < 16; ++r) { const int c = (r & 3) + 8 * (r >> 2); const int kpa = kp0 + c, kpb = kp0 + 32 + c;
      p0[r] = (kpa >= lo && kpa <= hi_) ? tp[c] : -1e30f; p1[r] = (kpb >= lo && kpb <= hi_) ? tp[32 + c] : -1e30f; }
  }
  __device__ __forceinline__ void epilogue(f32x16* o, float m_reg, float l_reg, float* li_l, char* lds) const {
    if (hi == 0) { li_l[r32] = l_reg; lse[(size_t)(b * SEQ + tok(pq)) * 4 + hb] = m_reg + __builtin_amdgcn_logf(l_reg); }
    asm volatile("s_waitcnt lgkmcnt(0)" ::: "memory");
    float rl[16];
#pragma unroll
    for (int r = 0; r < 16; ++r) rl[r] = __builtin_amdgcn_rcpf(li_l[crow(r, hi)]);
    __syncthreads();
    ATT_STORE_TILE(lds + wid * 8192, o[d][r] * rl[r], ob + (size_t)(b * SEQ + tok(P0 + 32 * wid + row)) * 512 + hb * 128);
    __syncthreads();
  }
};

struct PolC {
  static constexpr int ND = 8, NT = MEML / KVBLK;
  const bf16* qkv; const bf16* memkv; bf16* obuf; int b, h, q0, r32, hi, wid;
  __device__ __forceinline__ void init(const bf16* qkv_, const bf16* memkv_, bf16* obuf_, int b_, int h_, int q0_) {
    qkv = qkv_; memkv = memkv_; obuf = obuf_; b = b_; h = h_; q0 = q0_; const int tid = ltid(), lane = tid & 63; wid = tid >> 6; r32 = lane & 31; hi = lane >> 5; }
  __device__ __forceinline__ void prep(char*) const {}
  __device__ __forceinline__ const bf16* qptr() const { return qkv + QKV_AT(b, q0 + 32 * wid + r32, C_QC + h * 128); }
  __device__ __forceinline__ const bf16* krow(int t, int row) const { return memkv + (size_t)(b * MEML + 64 * t + row) * 4096 + h * 128; }
  __device__ __forceinline__ const bf16* vrow(int t, int row) const { return memkv + (size_t)(b * MEML + 64 * t + row) * 4096 + 512 + h * 128; }
  __device__ __forceinline__ int doff() const { return 0; }
  __device__ __forceinline__ void init_scores(f32x16& p0, f32x16& p1, int) const { p0 = f32x16{}; p1 = f32x16{}; }
  __device__ __forceinline__ void epilogue(f32x16* o, float m_reg, float l_reg, float* li_l, char* lds) const {
    if (hi == 0) li_l[r32] = l_reg; asm volatile("s_waitcnt lgkmcnt(0)" ::: "memory");
    float rl[16];
#pragma unroll
    for (int r = 0; r < 16; ++r) rl[r] = __builtin_amdgcn_rcpf(li_l[crow(r, hi)]);
    __syncthreads();
    ATT_STORE_TILE(lds + wid * 8192, o[d][r] * rl[r], obuf + (size_t)(b * SEQ + q0 + 32 * wid + row) * DM + 1536 + h * 128);
    __syncthreads();
  }
};
#undef SBAR
}

constexpr size_t MiB = 1u << 20;
constexpr size_t WS_CTL = 0, CTL_ZERO_BYTES = 2 * MiB;
constexpr size_t WS_X    = 2 * MiB;
constexpr size_t WS_H    = WS_X + 64 * MiB;
constexpr size_t WS_QKV  = WS_H + 32 * MiB;
constexpr size_t WS_HID  = WS_QKV;
constexpr size_t WS_GATE = WS_QKV + 128 * MiB;
constexpr size_t WS_OBUF = WS_GATE + 96 * MiB;
constexpr size_t WS_MRG  = WS_OBUF + 32 * MiB;
constexpr size_t WS_OB3  = WS_MRG + 32 * MiB;
constexpr size_t WS_LSE  = WS_OB3 + 48 * MiB;
constexpr size_t WS_MEMN = WS_LSE + 1 * MiB;
constexpr size_t WS_MEMKV= WS_MEMN + 4 * MiB;
constexpr size_t WS_WMEM = WS_MEMKV + 8 * MiB;
constexpr size_t WS_WIN  = WS_WMEM + 16 * MiB;
constexpr size_t WS_WPRJ = WS_WIN + 56 * MiB;
constexpr size_t WS_WOUT = WS_WPRJ + 8 * MiB;
constexpr size_t WS_WFF  = WS_WOUT + 8 * MiB;
constexpr size_t WS_WDN  = WS_WFF + 44 * MiB;
constexpr size_t WS_END  = WS_WDN + 22 * MiB;
constexpr int CW_BAR = 4096;

constexpr int RING_BYTES = 131072, LDSCTL_OFF = RING_BYTES, MISC_OFF = LDSCTL_OFF + 320, LDS_BYTES = 147456;
constexpr int NWAVES = 8;

#define LDS_WAIT() asm volatile("s_waitcnt lgkmcnt(0)" ::: "memory")
#define VM_WAIT() asm volatile("s_waitcnt vmcnt(0)" ::: "memory")

#define XB_TMO      128
#define XB_XCNT(j)  (256  + 64 * (j))
#define XB_XSUB(j)  (1280 + 64 * (j))
#define XB_XGEN(j)  (2304 + 64 * (j))
#define XB_TOP      3328
#define XB_TOPGEN   3392
#define XCD_BAR_WORDS 3456
#define XB_SPIN_CAP (1u << 18)
__device__ __forceinline__ unsigned xb_ld(unsigned* p)              { return __hip_atomic_load(p, __ATOMIC_RELAXED, __HIP_MEMORY_SCOPE_AGENT); }
__device__ __forceinline__ unsigned xb_add(unsigned* p, unsigned v) { return __hip_atomic_fetch_add(p, v, __ATOMIC_RELAXED, __HIP_MEMORY_SCOPE_AGENT); }
__device__ __forceinline__ unsigned xb_xcc_id() { return (unsigned)__builtin_amdgcn_s_getreg((3 << 11) | 20) & 0xFu; }
#define XB_SPIN(cond, bar) do { unsigned _sp = 0; while (cond) { __builtin_amdgcn_s_sleep(1); \
    if ((++_sp & 255u) == 0u) { if (xb_ld(&(bar)[XB_TMO])) break; if (_sp > XB_SPIN_CAP) { atomicAdd(&(bar)[XB_TMO], 1u); break; } } } } while (0)
struct XcdBarrier { unsigned* bar; unsigned x; volatile LAS unsigned* st; };
__device__ __forceinline__ XcdBarrier xcd_barrier_post(unsigned* bar, volatile LAS unsigned* st) {
    XcdBarrier b; b.bar = bar; b.x = xb_xcc_id(); b.st = st;
    if (threadIdx.x == 0) (void)xb_add(&bar[XB_XCNT(b.x)], 1u);
    return b;
}
__device__ __forceinline__ void xcd_barrier_complete(unsigned* bar, unsigned x, unsigned& nloc, unsigned& nx) {
    const unsigned G = gridDim.x * gridDim.y * gridDim.z;
    unsigned sum, cnt, mine, sp = 0u;
    for (;;) {
        sum = 0u; cnt = 0u; mine = 0u;
#pragma unroll
        for (unsigned j = 0; j < 16; ++j) { const unsigned c = xb_ld(&bar[XB_XCNT(j)]); sum += c; cnt += (c > 0u) ? 1u : 0u; mine = (j == x) ? c : mine; }
        if (sum == G) break;
        __builtin_amdgcn_s_sleep(1);
        if ((++sp & 255u) == 0u) { if (xb_ld(&bar[XB_TMO])) break; if (sp > XB_SPIN_CAP) { atomicAdd(&bar[XB_TMO], 1u); break; } }
    }
    nloc = mine > 0u ? mine : 1u; nx = cnt > 0u ? cnt : 1u;
}
__device__ __forceinline__ void xcd_barrier(const XcdBarrier& b) {
    asm volatile("s_waitcnt vmcnt(0)" ::: "memory");
    __syncthreads();
    if (threadIdx.x == 0) {
        unsigned* bar = b.bar;
        __builtin_amdgcn_s_waitcnt(0);
        unsigned nloc = b.st[0], nx = b.st[1];
        if (nloc == 0u) { xcd_barrier_complete(bar, b.x, nloc, nx); b.st[0] = nloc; b.st[1] = nx; }
        const unsigned old = xb_add(&bar[XB_XSUB(b.x)], 1u);
        const unsigned gen = old / nloc;
        if (old + 1u == (gen + 1u) * nloc) {
            __builtin_amdgcn_fence(__ATOMIC_RELEASE, "agent");
            asm volatile("s_waitcnt vmcnt(0)" ::: "memory");
            const unsigned og = xb_add(&bar[XB_TOP], 1u);
            const unsigned tg = og / nx;
            if (og + 1u == (tg + 1u) * nx) xb_add(&bar[XB_TOPGEN], 1u);
            else XB_SPIN(xb_ld(&bar[XB_TOPGEN]) == tg, bar);
            __builtin_amdgcn_fence(__ATOMIC_ACQUIRE, "agent");
            xb_add(&bar[XB_XGEN(b.x)], 1u);
            asm volatile("s_waitcnt vmcnt(0)" ::: "memory");
        } else {
            XB_SPIN(xb_ld(&bar[XB_XGEN(b.x)]) == gen, bar);
            __builtin_amdgcn_fence(__ATOMIC_ACQUIRE, "agent");
            asm volatile("s_waitcnt vmcnt(0)" ::: "memory");
        }
    }
    __syncthreads();
}

__device__ __forceinline__ float wave_sum(float v) {
#pragma unroll
    for (int o = 1; o < 64; o <<= 1) v += __shfl_xor(v, o);
    return v;
}
__device__ __forceinline__ unsigned pkbf(float lo, float hi) { return pg8::cvt_pk_bf16(lo, hi); }

__device__ __forceinline__ void rms_row_bf16(const float* xrow, const float* gain, bf16* orow, int lane) {
    const f32x4* xr = (const f32x4*)xrow + lane; const f32x4* gr = (const f32x4*)gain + lane;
    f32x4 v[8]; float s = 0.f;
#pragma unroll
    for (int j = 0; j < 8; ++j) { v[j] = xr[64 * j]; s += (v[j].x * v[j].x + v[j].y * v[j].y) + (v[j].z * v[j].z + v[j].w * v[j].w); }
    const float rstd = 1.0f / sqrtf(wave_sum(s) * (1.f / DM) + EPS);
    v2u* o8 = (v2u*)orow + lane;
#pragma unroll
    for (int j = 0; j < 8; ++j) { const f32x4 g = gr[64 * j]; v2u w; w.x = pkbf(v[j].x * rstd * g.x, v[j].y * rstd * g.y); w.y = pkbf(v[j].z * rstd * g.z, v[j].w * rstd * g.w); o8[64 * j] = w; }
}
__device__ __forceinline__ void rms_row_f32(const float* xrow, const float* gain, float* orow, int lane) {
    const f32x4* xr = (const f32x4*)xrow + lane; const f32x4* gr = (const f32x4*)gain + lane;
    f32x4 v[8]; float s = 0.f;
#pragma unroll
    for (int j = 0; j < 8; ++j) { v[j] = xr[64 * j]; s += (v[j].x * v[j].x + v[j].y * v[j].y) + (v[j].z * v[j].z + v[j].w * v[j].w); }
    const float rstd = 1.0f / sqrtf(wave_sum(s) * (1.f / DM) + EPS);
    f32x4* o = (f32x4*)orow + lane;
#pragma unroll
    for (int j = 0; j < 8; ++j) { const f32x4 g = gr[64 * j]; o[64 * j] = v[j] * rstd * g; }
}

struct WtDesc { const float* W; const float* gn; bf16* dst; int N, ldk; };
__device__ __forceinline__ void wt_load(f32x4 (&v)[16], float (&gv)[16], const WtDesc& D, int lane) {
    const float* src = D.W + (size_t)(16 * (lane >> 4)) * D.N + 4 * (lane & 15);
#pragma unroll
    for (int i = 0; i < 16; ++i) v[i] = __builtin_nontemporal_load((const f32x4*)(src + (size_t)i * D.N));
    if (D.gn) { const f32x4* g4 = (const f32x4*)(D.gn + 16 * (lane >> 4));
#pragma unroll
        for (int i = 0; i < 4; ++i) { const f32x4 g = g4[i]; gv[4 * i] = g.x; gv[4 * i + 1] = g.y; gv[4 * i + 2] = g.z; gv[4 * i + 3] = g.w; } }
    else {
#pragma unroll
        for (int i = 0; i < 16; ++i) gv[i] = 1.0f; }
}
__device__ __forceinline__ void wt_proc_a(const f32x4 (&v)[16], const float (&gv)[16], LAS unsigned char* T, int lane) {
    LAS unsigned char* tw = T + (4 * (lane & 15)) * 144 + (16 * (lane >> 4)) * 2;
#pragma unroll
    for (int i4 = 0; i4 < 4; ++i4) { const f32x4 a = v[4 * i4] * gv[4 * i4], b = v[4 * i4 + 1] * gv[4 * i4 + 1], c = v[4 * i4 + 2] * gv[4 * i4 + 2], d = v[4 * i4 + 3] * gv[4 * i4 + 3];
#pragma unroll
        for (int cc = 0; cc < 4; ++cc) { v2u w; w.x = pkbf(a[cc], b[cc]); w.y = pkbf(c[cc], d[cc]); *(LAS v2u*)(tw + cc * 144 + i4 * 8) = w; } }
    LDS_WAIT(); asm volatile("" ::: "memory");
}
__device__ __forceinline__ void wt_proc_b(const WtDesc& D, LAS unsigned char* T, int lane) {
    const LAS unsigned char* tr = T + (lane >> 3) * 144 + (lane & 7) * 16;
    bf16* dst = D.dst + (size_t)(lane >> 3) * D.ldk + (lane & 7) * 8;
    v4u w[8];
#pragma unroll
    for (int r = 0; r < 8; ++r) w[r] = *(const LAS v4u*)(tr + r * 8 * 144);
#pragma unroll
    for (int r = 0; r < 8; ++r) __builtin_nontemporal_store(w[r], (v4u*)(dst + (size_t)(8 * r) * D.ldk));
    LDS_WAIT(); asm volatile("" ::: "memory");
}
__device__ __forceinline__ void wt_proc(const f32x4 (&v)[16], const float (&gv)[16], const WtDesc& D, LAS unsigned char* T, int lane) { wt_proc_a(v, gv, T, lane); wt_proc_b(D, T, lane); }
__device__ __forceinline__ void wt_item(const float* W, int N, int k0, int n0, bf16* wt0, int ldk, LAS unsigned char* T, int lane, const float* gain = nullptr) {
    WtDesc D; D.W = W + (size_t)k0 * N + n0; D.gn = gain ? gain + k0 : nullptr; D.dst = wt0; D.N = N; D.ldk = ldk;
    f32x4 v[16]; float gv[16]; wt_load(v, gv, D, lane); wt_proc(v, gv, D, T, lane);
}
constexpr int IT_WIN = (DM / 64) * (NIN / 64), IT_WGATE = (DM / 64) * (NGATE / 64), IT_PA = (1024 / 64) * (DM / 64), IT_PB = (512 / 64) * (DM / 64), IT_PC = IT_PB,
              IT_WOUT = (DM / 64) * (DM / 64), IT_FG = (DM / 64) * (DFF / 64), IT_FU = IT_FG, IT_FD = (DFF / 64) * (DM / 64);
constexpr int IT_E0 = IT_WIN, IT_E1 = IT_E0 + IT_WGATE, IT_E2 = IT_E1 + IT_PA, IT_E3 = IT_E2 + IT_PB, IT_E4 = IT_E3 + IT_PC, IT_E5 = IT_E4 + IT_WOUT, IT_E6 = IT_E5 + IT_FG, IT_E7 = IT_E6 + IT_FU, IT_E8 = IT_E7 + IT_FD;
struct Args {
    const float* in[20]; float* out; unsigned char* ws; int ph_lo, ph_hi, li, pad;
};
constexpr int PH_PRO = 0, PH_MEMKV = 1, PH_L0 = 2, PH_PER_LAYER = 7, PH_FINAL = PH_L0 + DEPTH * PH_PER_LAYER, PH_N = PH_FINAL + 1;
constexpr int CW_QUEUE = 150000;
constexpr int CW_SS = 262144;
static_assert((size_t)CW_SS * 4 + (size_t)9 * MTOK * 8 <= CTL_ZERO_BYTES && CW_BAR + 40 * XCD_BAR_WORDS <= CW_QUEUE, "CTL map");

#define CONV_DECODE(D_, it_, lw_) do { const int ci_ = (it_); const int clw_ = (lw_); \
        const float* W; int K, N, ldk, koff, r, swz; bf16* WT; int rowoff; const float* gn = nullptr; \
        if (ci_ < IT_E0)      { r = ci_;         W = INP(5) + (size_t)clw_ * DM * NIN;    K = DM;   N = NIN;   WT = P_WIN;  ldk = DM;  koff = 0;    rowoff = 0;   swz = -1; gn = INP(4) + clw_ * DM; } \
        else if (ci_ < IT_E1) { r = ci_ - IT_E0; W = INP(9) + (size_t)clw_ * DM * NGATE;  K = DM;   N = NGATE; WT = P_WIN;  ldk = DM;  koff = 0;    rowoff = NIN; swz = -1; gn = INP(4) + clw_ * DM; } \
        else if (ci_ < IT_E2) { r = ci_ - IT_E1; W = INP(11) + (size_t)clw_ * 1024 * DM;  K = 1024; N = DM;    WT = P_WPRJ; ldk = DM;  koff = 0;    rowoff = 0;   swz = -1; } \
        else if (ci_ < IT_E3) { r = ci_ - IT_E2; W = INP(12) + (size_t)clw_ * 512 * DM;   K = 512;  N = DM;    WT = P_WPRJ; ldk = DM;  koff = 1024; rowoff = 0;   swz = -1; } \
        else if (ci_ < IT_E4) { r = ci_ - IT_E3; W = INP(13) + (size_t)clw_ * 512 * DM;   K = 512;  N = DM;    WT = P_WPRJ; ldk = DM;  koff = 1536; rowoff = 0;   swz = -1; } \
        else if (ci_ < IT_E5) { r = ci_ - IT_E4; W = INP(14) + (size_t)clw_ * DM * DM;    K = DM;   N = DM;    WT = P_WOUT; ldk = DM;  koff = 0;    rowoff = 0;   swz = -1; } \
        else if (ci_ < IT_E6) { r = ci_ - IT_E5; W = INP(16) + (size_t)clw_ * DM * DFF;   K = DM;   N = DFF;   WT = P_WFF;  ldk = DM;  koff = 0;    rowoff = 0;   swz = 0; gn = INP(15) + clw_ * DM; } \
        else if (ci_ < IT_E7) { r = ci_ - IT_E6; W = INP(17) + (size_t)clw_ * DM * DFF;   K = DM;   N = DFF;   WT = P_WFF;  ldk = DM;  koff = 0;    rowoff = 0;   swz = 1; gn = INP(15) + clw_ * DM; } \
        else                 { r = ci_ - IT_E7; W = INP(18) + (size_t)clw_ * DFF * DM;   K = DFF;  N = DM;    WT = P_WDN;  ldk = DFF; koff = 0;    rowoff = 0;   swz = -1; } \
        const int nnb = N >> 6, kb = r / nnb, nb = r - kb * nnb, n0 = nb * 64, k0 = kb * 64;     \
        const int drow = swz < 0 ? (rowoff + n0) : ((n0 >> 7) * 256 + swz * 128 + (n0 & 127)); \
        (D_).W = W + (size_t)k0 * N + n0; (D_).gn = gn ? gn + k0 : nullptr; (D_).dst = WT + (size_t)drow * ldk + koff + k0; (D_).N = N; (D_).ldk = ldk; } while (0)
#define CONV_ITEM(it_, lw_) do { WtDesc D_; CONV_DECODE(D_, it_, lw_); f32x4 v_[16]; float g_[16]; wt_load(v_, g_, D_, lane); wt_proc(v_, g_, D_, Twave, lane); } while (0)

__global__ void __launch_bounds__(NWAVES * 64, 2) trunk_fwd(Args args) {
    extern __shared__ __attribute__((aligned(16))) unsigned char lds[];
    LAS unsigned char* ldsl = (LAS unsigned char*)lds;
    volatile LAS unsigned* MISC = (volatile LAS unsigned*)(ldsl + MISC_OFF);
    const int tid = threadIdx.x, wave = __builtin_amdgcn_readfirstlane(tid >> 6);
#define LANE() (att::ltid() & 63)
    const int G = gridDim.x; const int bx = blockIdx.x; const int vcu = (G % 8 == 0) ? (bx % 8) * (G / 8) + bx / 8 : bx;
    const int gw = vcu * NWAVES + wave, NGW = G * NWAVES;
    typedef const __attribute__((address_space(4))) Args* KArgs;
    unsigned long long ka_bits = (unsigned long long)__builtin_amdgcn_kernarg_segment_ptr();
#define KA() ({ asm volatile("" : "+s"(ka_bits)); (KArgs)ka_bits; })
#define WSP(off) ((unsigned char*)KA()->ws + (off))
#define INP(k) (KA()->in[k])
    unsigned* ctl = (unsigned*)WSP(WS_CTL);
    for (int u = tid; u < (LDS_BYTES - LDSCTL_OFF) / 4; u += NWAVES * 64) ((LAS unsigned*)(ldsl + LDSCTL_OFF))[u] = 0u;
    __syncthreads();
    XcdBarrier bar = xcd_barrier_post(ctl + CW_BAR + KA()->li * XCD_BAR_WORDS, MISC + 8);
    const int lo = KA()->ph_lo, hi = KA()->ph_hi;
#define IN(k) (lo <= (k) && (k) < hi)
#define SEAM(k) do { if (IN(k) && IN((k) + 1)) xcd_barrier(bar); } while (0)

#define P_X      ((float*)WSP(WS_X))
#define P_XB     ((bf16*)WSP(WS_H))
#define P_QKV    ((bf16*)WSP(WS_QKV))
#define P_HID    ((bf16*)WSP(WS_HID))
#define P_GATE   ((bf16*)WSP(WS_GATE))
#define P_OBUF   ((bf16*)WSP(WS_OBUF))
#define P_MRG    ((bf16*)WSP(WS_MRG))
#define P_OB3    ((bf16*)WSP(WS_OB3))
#define P_LSE    ((float*)WSP(WS_LSE))
#define P_MEMN   ((bf16*)WSP(WS_MEMN))
#define P_MEMKV  ((bf16*)WSP(WS_MEMKV))
#define P_WMEM   ((bf16*)WSP(WS_WMEM))
#define P_WIN    ((bf16*)WSP(WS_WIN))
#define P_WPRJ   ((bf16*)WSP(WS_WPRJ))
#define P_WOUT   ((bf16*)WSP(WS_WOUT))
#define P_WFF    ((bf16*)WSP(WS_WFF))
#define P_WDN    ((bf16*)WSP(WS_WDN))
#define P_SS(i)  ((unsigned long long*)((unsigned*)WSP(WS_CTL) + CW_SS) + (i) * MTOK)
    LAS unsigned char* Twave = ldsl + wave * 9216;

    if (IN(PH_PRO)) {
        const int lane = LANE();
        { const float* w_mem_kv = INP(8); bf16* WMEM = P_WMEM;
          for (int it = gw; it < DEPTH * (DM / 64) * (1024 / 64); it += NGW) { const int l = it >> 9, r = it & 511, kb = r >> 4, nb = r & 15;
              wt_item(w_mem_kv + (size_t)l * DM * 1024, 1024, kb * 64, nb * 64, WMEM + (size_t)(l * 1024 + nb * 64) * DM + kb * 64, DM, Twave, lane); } }
        { const float* mem = INP(1); const float* mem_norm = INP(3); bf16* MEMN = P_MEMN;
          for (int m = gw; m < NB * MEML; m += NGW) rms_row_bf16(mem + (size_t)m * DM, mem_norm, MEMN + (size_t)m * DM, lane); }
    }
    SEAM(PH_PRO);
    if (IN(PH_MEMKV)) {
        constexpr int NMU = (NB * MEML / 256) * (4096 / 256);
        { pg8::Gemm g{P_MEMN, P_WMEM, NB * MEML, 4096, DM}; pg8::StaticOrder S; S.init(NB * MEML, 4096, G, bx);
            pg8::EpiPlain E{P_MEMKV, 4096};
            pg8::gemm_phase<pg8::EpiPlain, pg8::StaticOrder, true, true>(ldsl, g, S, E); }
        const bool split = G > 2 * NMU;
        if (!split || bx >= NMU) {
            const int lane = LANE();
            const int tgw = split ? (bx - NMU) * NWAVES + wave : bx * NWAVES + wave, tngw = split ? (G - NMU) * NWAVES : G * NWAVES;
            for (int it = tgw; it < IT_E1; it += tngw) CONV_ITEM(it, 0);
            { const float* xin = INP(0); bf16* XB = P_XB; unsigned long long* ss0 = P_SS(0);
              for (int m = tgw; m < MTOK; m += tngw) { const f32x4* xr = (const f32x4*)(xin + (size_t)m * DM) + lane; v2u* o8 = (v2u*)(XB + (size_t)m * DM) + lane; float sq = 0.f;
#pragma unroll
                  for (int j = 0; j < 8; ++j) { const f32x4 v = xr[64 * j]; v2u w; w.x = pkbf(v.x, v.y); w.y = pkbf(v.z, v.w); o8[64 * j] = w;
                      const float r0 = pg8::bf_lo(w.x), r1 = pg8::bf_hi(w.x), r2 = pg8::bf_lo(w.y), r3 = pg8::bf_hi(w.y); sq += (r0 * r0 + r1 * r1) + (r2 * r2 + r3 * r3); }
                  sq = wave_sum(sq); if (lane == 0) ss0[m] = (unsigned long long)(sq * 1048576.0f + 0.5f); } }
        }
    }
    SEAM(PH_MEMKV);

    for (int l = 0; l < DEPTH; ++l) {
        const int pb = PH_L0 + l * PH_PER_LAYER;
        if (IN(pb + 0)) {
            pg8::Gemm g{P_XB, P_WIN, MTOK, NIN + NGATE, DM}; pg8::StaticOrder S; S.init(MTOK, NIN + NGATE, G, bx);
            pg8::EpiInGate E{P_QKV, P_GATE, INP(10) + (size_t)l * NGATE, P_SS(2 * l)};
            pg8::gemm_phase<pg8::EpiInGate, pg8::StaticOrder, true, true>(ldsl, g, S, E);
        }
        SEAM(pb + 0);
        if (IN(pb + 1)) {
            float lam, post;
            { const int lane = LANE(); const float* dl = INP(6) + (size_t)l * 256; const float s1 = wave_sum(dl[lane] * dl[64 + lane]), s2 = wave_sum(dl[128 + lane] * dl[192 + lane]);
              const float lam_init = 0.8f - 0.6f * expf(-0.3f * (float)l); const float lamv = expf(s1) - expf(s2) + lam_init;
              lam = __uint_as_float(__builtin_amdgcn_readfirstlane(__float_as_uint(lamv))); post = __uint_as_float(__builtin_amdgcn_readfirstlane(__float_as_uint(lam_init))); }
            constexpr int NCH = 170, IPC = 104, NLOC = IT_E8 - IT_E1;
            static_assert(NCH * IPC >= IT_E8, "conversion chunks cover every item");
            const int TI = NLOC + (l + 1 < DEPTH ? IT_E1 : 0);
            const int qx = bx & 7, ncx = (NCH - qx + 7) >> 3, QR = 64 + ncx;
            unsigned* qhead = ctl + CW_QUEUE + 64 * (l * 8 + qx);
            for (;;) {
                __syncthreads();
                if (tid == 0) MISC[16] = __hip_atomic_fetch_add(qhead, 1u, __ATOMIC_RELAXED, __HIP_MEMORY_SCOPE_AGENT);
                __syncthreads();
                const int u = __builtin_amdgcn_readfirstlane((int)MISC[16]);
                if (u >= QR + 64) break;
                if (u < QR) {
                    if ((u & 3) == 0 && (u >> 2) < ncx) {
                        const int c = qx + 8 * (u >> 2); const int lane = LANE();
                        int j = c * IPC + wave; const int jend = (c + 1) * IPC < TI ? (c + 1) * IPC : TI;
#define JDEC(D, jj) do { const int jj_ = (jj); if (jj_ < NLOC) CONV_DECODE(D, IT_E1 + jj_, l); else CONV_DECODE(D, jj_ - NLOC, l + 1); } while (0)
                        if (j < jend) {
                            WtDesc D; f32x4 v[16]; float gv[16];
                            JDEC(D, j); wt_load(v, gv, D, lane);
                            for (;;) {
                                const int j1 = j + 8; const bool h1 = j1 < jend;
                                WtDesc Dn; if (h1) JDEC(Dn, j1);
                                wt_proc_a(v, gv, Twave, lane);
                                if (h1) wt_load(v, gv, Dn, lane);
                                wt_proc_b(D, Twave, lane);
                                if (!h1) break;
                                D = Dn; j = j1;
                            }
                        }
#undef JDEC
                        LDS_WAIT();
                    } else {
                        const int cb = (u >> 2) + 1, al = u - (cb < ncx ? cb : ncx), au = (qx * 4 + (al >> 4)) * 16 + (al & 15);
                        const int chunk = au & 15, h = (au >> 4) & 7, b = au >> 7;
                        att::PolA P; P.init(P_QKV, P_OBUF, INP(7) + l * 128, lam, post, b, h, chunk * 128, INP(2), (char*)lds);
                        att::attn_unit<att::PolA>(P, (char*)lds);
                    }
                } else if (u < QR + 48) { {
                    const int su = qx * 48 + (u - QR); const int g_ = su % 3, r = su / 3, chunk = r & 7, hb = (r >> 3) & 3, b = r >> 5;
                    att::PolB P; P.init(P_QKV, P_OB3 + (size_t)g_ * MTOK * 512, P_LSE + (size_t)g_ * MTOK * 4, b, g_, hb, chunk * 256, INP(2), (char*)lds);
                    att::attn_unit<att::PolB>(P, (char*)lds); }
                } else { {
                    const int r = qx * 16 + (u - QR - 48), chunk = r & 7, h = (r >> 3) & 3, b = r >> 5;
                    att::PolC P; P.init(P_QKV, P_MEMKV + l * 1024, P_OBUF, b, h, chunk * 256);
                    att::attn_unit<att::PolC>(P, (char*)lds); }
                }
            }
        }
        SEAM(pb + 1);
        if (IN(pb + 2)) {
            const int lane = LANE();
            const float* LSE = P_LSE; const bf16* OB3 = P_OB3; bf16* OBUF = P_OBUF;
            for (int m = gw; m < MTOK; m += NGW) {
                const int hb = lane >> 4;
                const float l0 = LSE[(size_t)m * 4 + hb], l1 = LSE[(size_t)(MTOK + m) * 4 + hb], l2 = LSE[(size_t)(2 * MTOK + m) * 4 + hb];
                const float mx = fmaxf(l0, fmaxf(l1, l2));
                float a0 = __builtin_amdgcn_exp2f(l0 - mx), a1 = __builtin_amdgcn_exp2f(l1 - mx), a2 = __builtin_amdgcn_exp2f(l2 - mx);
                const float inv = 1.0f / (a0 + a1 + a2); a0 *= inv; a1 *= inv; a2 *= inv;
                const bf16* p0 = OB3 + (size_t)m * 512 + lane * 8;
                const v4u u = *(const v4u*)p0, v = *(const v4u*)(p0 + (size_t)MTOK * 512), w3 = *(const v4u*)(p0 + (size_t)2 * MTOK * 512);
#define CMB(x_) (pg8::bf_lo(u.x_) * a0 + pg8::bf_lo(v.x_) * a1 + pg8::bf_lo(w3.x_) * a2), (pg8::bf_hi(u.x_) * a0 + pg8::bf_hi(v.x_) * a1 + pg8::bf_hi(w3.x_) * a2)
                v4u w; w.x = pkbf(CMB(x)); w.y = pkbf(CMB(y)); w.z = pkbf(CMB(z)); w.w = pkbf(CMB(w));
#undef CMB
                *(v4u*)(OBUF + (size_t)m * DM + 1024 + lane * 8) = w;
            }
        }
        SEAM(pb + 2);
        if (IN(pb + 3)) {
            pg8::Gemm g{P_OBUF, P_WPRJ, MTOK, DM, DM}; pg8::StaticOrder S; S.init(MTOK, DM, G, bx);
            pg8::EpiProj E{P_GATE, P_MRG};
            pg8::gemm_phase<pg8::EpiProj, pg8::StaticOrder, true, true>(ldsl, g, S, E);
        }
        SEAM(pb + 3);
        if (IN(pb + 4)) {
            pg8::Gemm g{P_MRG, P_WOUT, MTOK, DM, DM}; pg8::StaticOrder S; S.init(MTOK, DM, G, bx);
            pg8::EpiResid E{(l == 0) ? INP(0) : (const float*)nullptr, P_XB, P_SS(2 * l + 1)};
            pg8::gemm_phase<pg8::EpiResid, pg8::StaticOrder, true, true>(ldsl, g, S, E);
        }
        SEAM(pb + 4);
        if (IN(pb + 5)) {
            pg8::Gemm g{P_XB, P_WFF, MTOK, 2 * DFF, DM}; pg8::StaticOrder S; S.init(MTOK, 2 * DFF, G, bx);
            pg8::EpiSwiGLU E{P_HID, P_SS(2 * l + 1)};
            pg8::gemm_phase<pg8::EpiSwiGLU, pg8::StaticOrder, true, true>(ldsl, g, S, E);
        }
        SEAM(pb + 5);
        if (IN(pb + 6)) {
            pg8::Gemm g{P_HID, P_WDN, MTOK, DM, DFF}; pg8::StaticOrder S; S.init(MTOK, DM, G, bx);
            pg8::EpiResid E{nullptr, P_XB, P_SS(2 * l + 2)};
            pg8::gemm_phase<pg8::EpiResid, pg8::StaticOrder, true, true>(ldsl, g, S, E);
        }
        SEAM(pb + 6);
    }
    if (IN(PH_FINAL)) {
        const int lane = LANE();
        const bf16* Xp = P_XB; const float* gn = INP(19); float* outp = KA()->out; const unsigned long long* ss = P_SS(8);
        for (int m = gw; m < MTOK; m += NGW) { const float rstd = 1.0f / sqrtf((float)ss[m] * (1.f / (DM * 1048576.0f)) + EPS);
            const v2u* xr = (const v2u*)(Xp + (size_t)m * DM) + lane; const f32x4* gr = (const f32x4*)gn + lane; f32x4* o = (f32x4*)(outp + (size_t)m * DM) + lane;
#pragma unroll
            for (int j = 0; j < 8; ++j) { const v2u p = xr[64 * j]; const f32x4 x = (f32x4){pg8::bf_lo(p.x), pg8::bf_hi(p.x), pg8::bf_lo(p.y), pg8::bf_hi(p.y)}; o[64 * j] = x * rstd * gr[64 * j]; } }
    }
#undef IN
#undef SEAM
}

extern "C" void kernel_launch(void* const* d_in, const int* in_sizes, int n_in, void* d_out, int out_size, void* d_ws, size_t ws_size, hipStream_t stream) {
    static int grid = 0;
    if (grid == 0) {
        if (n_in != 20 || out_size != MTOK * DM || ws_size < WS_END) { fprintf(stderr, "kernel_launch: unexpected shapes: n_in %d out %d ws %zu (need %zu)\n", n_in, out_size, ws_size, (size_t)WS_END); grid = -1; return; }
        int dev = 0, cus = 0, per_cu = 0;
        if (hipGetDevice(&dev) != hipSuccess || hipDeviceGetAttribute(&cus, hipDeviceAttributeMultiprocessorCount, dev) != hipSuccess) { grid = -1; return; }
        if (hipFuncSetAttribute((const void*)trunk_fwd, hipFuncAttributeMaxDynamicSharedMemorySize, LDS_BYTES) != hipSuccess) { fprintf(stderr, "kernel_launch: hipFuncSetAttribute failed\n"); grid = -1; return; }
        if (hipOccupancyMaxActiveBlocksPerMultiprocessor(&per_cu, (const void*)trunk_fwd, NWAVES * 64, LDS_BYTES) != hipSuccess || per_cu < 1)
            fprintf(stderr, "kernel_launch: occupancy query reports %d workgroups per CU\n", per_cu);
        (void)hipGetLastError();
        grid = cus;
    }
    if (grid < 0) return;
    if (hipMemsetAsync((char*)d_ws + WS_CTL, 0, CTL_ZERO_BYTES, stream) != hipSuccess) { fprintf(stderr, "kernel_launch: memset failed\n"); return; }
    Args a{};
    for (int i = 0; i < 20; ++i) a.in[i] = (const float*)d_in[i];
    a.out = (float*)d_out; a.ws = (unsigned char*)d_ws; a.pad = 0;
#if MK_PER_PHASE
    for (int p = 0; p < PH_N; ++p) { a.ph_lo = p; a.ph_hi = p + 1; a.li = p;
        hipLaunchKernelGGL(trunk_fwd, dim3(grid), dim3(NWAVES * 64), LDS_BYTES, stream, a); }
#else
    a.ph_lo = 0; a.ph_hi = PH_N; a.li = 0;
    hipLaunchKernelGGL(trunk_fwd, dim3(grid), dim3(NWAVES * 64), LDS_BYTES, stream, a);
#endif
    const hipError_t le = hipPeekAtLastError();
    if (le != hipSuccess) fprintf(stderr, "kernel_launch: launch failed: %s\n", hipGetErrorName(le));
}
```
